# Optimizing an MI355X kernel written in HIP

```python
import math
import jax, jax.numpy as jnp
from jax import lax
import numpy as np

D_MODEL = 1024
BATCH = 16
SEQ = 4096
DEPTH = 1
DEC_BATCH = 2
DEC_SEQ = 16384
PAST_LEN = 128

ATTN_WIDTH = D_MODEL // 2
CONV_WIDTH = D_MODEL - ATTN_WIDTH
N_HEADS = 4
HEAD_DIM = ATTN_WIDTH // N_HEADS // 2
V_DIM = 2 * HEAD_DIM
QK_WIDTH = N_HEADS * 2 * HEAD_DIM
IN_WIDTH = 2 * QK_WIDTH + ATTN_WIDTH + 2 * CONV_WIDTH
ROT_DIM = HEAD_DIM // 4
ROPE_THETA = 500000.0
CONV_KERNEL = 31
CONV_PAD = CONV_KERNEL // 2
N_GROUPS = 4
EXPERTS_PER_GROUP = 8
N_EXPERTS = N_GROUPS * EXPERTS_PER_GROUP
TOP_K = 2
EXPERT_FF = 512
Q_BLOCK = 128
MOE_BLOCK = 128
EPS = 1e-6

kernel_name = 'hymba_diffattn_conformer_hmoe_encoder'


def rms_norm(x, g):
    xf = x.astype(jnp.float32)
    y = xf * lax.rsqrt(jnp.mean(xf * xf, axis=-1, keepdims=True) + EPS)
    return (y * g.astype(jnp.float32)).astype(x.dtype)


def layer_norm(x, g, b):
    xf = x.astype(jnp.float32)
    mu = jnp.mean(xf, axis=-1, keepdims=True)
    var = jnp.mean(jnp.square(xf - mu), axis=-1, keepdims=True)
    y = (xf - mu) * lax.rsqrt(var + EPS)
    return (y * g.astype(jnp.float32) + b.astype(jnp.float32)).astype(x.dtype)


def modulate(h, shift, scale):
    return h * (1.0 + scale[:, None, :]) + shift[:, None, :]


def apply_rotary(x, pos):
    inv_freq = ROPE_THETA ** (-jnp.arange(0, ROT_DIM, 2, dtype=jnp.float32) / ROT_DIM)
    ang = pos[:, None] * inv_freq[None, :]
    cos = jnp.cos(ang)[:, None, None, :]
    sin = jnp.sin(ang)[:, None, None, :]
    xr = x[..., :ROT_DIM].astype(jnp.float32)
    x1 = xr[..., :ROT_DIM // 2]
    x2 = xr[..., ROT_DIM // 2:]
    rot = jnp.concatenate([x1 * cos - x2 * sin, x2 * cos + x1 * sin], axis=-1).astype(x.dtype)
    return jnp.concatenate([rot, x[..., ROT_DIM:]], axis=-1)


def diff_attention(q, k, v, lam):
    b, s = q.shape[0], q.shape[1]
    nq = s // Q_BLOCK
    qb = q.reshape(b, nq, Q_BLOCK, N_HEADS, 2, HEAD_DIM).transpose(1, 0, 2, 3, 4, 5)
    scale = HEAD_DIM ** -0.5

    def one_block(qi):
        sc = jnp.einsum('bqhcd,bkhcd->bhcqk', qi, k).astype(jnp.float32) * scale
        p = jax.nn.softmax(sc, axis=-1)
        a = p[:, :, 0] - lam * p[:, :, 1]
        return jnp.einsum('bhqk,bkhe->bqhe', a.astype(v.dtype), v)

    o = lax.map(one_block, qb)
    return o.transpose(1, 0, 2, 3, 4).reshape(b, s, N_HEADS, V_DIM)


def conformer_conv(u, w_dw, b_dw, g_ln, b_ln):
    a, gate = jnp.split(u, 2, axis=-1)
    z = a * jax.nn.sigmoid(gate)
    z = lax.conv_general_dilated(z, w_dw[:, None, :].astype(z.dtype), window_strides=(1,),
                                 padding=[(CONV_PAD, CONV_PAD)],
                                 dimension_numbers=('NWC', 'WIO', 'NWC'),
                                 feature_group_count=CONV_WIDTH) + b_dw
    return jax.nn.silu(layer_norm(z, g_ln, b_ln))


def hier_moe(h, w_rg, b_rg, w_re, b_re, w_gate_up, w_down):
    t, d = h.shape
    lg = (h @ w_rg).astype(jnp.float32) + b_rg
    pg = jax.nn.softmax(lg, axis=-1)
    g_sel = jnp.argmax(lg, axis=-1)
    p_group = jnp.take_along_axis(pg, g_sel[:, None], axis=1)[:, 0]
    le = ((h @ w_re).astype(jnp.float32) + b_re).reshape(t, N_GROUPS, EXPERTS_PER_GROUP)
    le_g = jnp.take_along_axis(le, g_sel[:, None, None], axis=1)[:, 0]
    pe = jax.nn.softmax(le_g, axis=-1)
    top_p, top_i = lax.top_k(pe, TOP_K)
    top_p = top_p / jnp.sum(top_p, axis=-1, keepdims=True)
    gates = p_group[:, None] * top_p
    eids = g_sel[:, None] * EXPERTS_PER_GROUP + top_i

    n_assign = t * TOP_K
    e_flat = eids.reshape(n_assign).astype(jnp.int32)
    t_flat = jnp.repeat(jnp.arange(t, dtype=jnp.int32), TOP_K)
    w_flat = gates.reshape(n_assign)
    order = jnp.argsort(e_flat)
    e_s, t_s, w_s = e_flat[order], t_flat[order], w_flat[order]
    counts = jax.ops.segment_sum(jnp.ones((n_assign,), jnp.int32), e_flat, num_segments=N_EXPERTS)
    starts = jnp.cumsum(counts) - counts
    padded = ((counts + MOE_BLOCK - 1) // MOE_BLOCK) * MOE_BLOCK
    pad_ends = jnp.cumsum(padded)
    pad_starts = pad_ends - padded
    rank = jnp.arange(n_assign, dtype=jnp.int32) - starts[e_s]
    dest = pad_starts[e_s] + rank
    n_rows = n_assign + N_EXPERTS * MOE_BLOCK
    n_blk = n_rows // MOE_BLOCK
    row_tok = jnp.full((n_rows,), t, jnp.int32).at[dest].set(t_s)
    row_w = jnp.zeros((n_rows,), jnp.float32).at[dest].set(w_s)
    blk_start = jnp.arange(n_blk, dtype=jnp.int32) * MOE_BLOCK
    blk_eid = jnp.minimum(jnp.searchsorted(pad_ends, blk_start, side='right'), N_EXPERTS - 1).astype(jnp.int32)
    h_pad = jnp.concatenate([h, jnp.zeros((1, d), h.dtype)], axis=0)
    xg = h_pad[row_tok].reshape(n_blk, MOE_BLOCK, d)

    def expert_block(args):
        xb, e = args
        gu = xb @ w_gate_up[e]
        g_, u_ = jnp.split(gu, 2, axis=-1)
        return (jax.nn.silu(g_) * u_) @ w_down[e]

    yb = lax.map(expert_block, (xg, blk_eid)).reshape(n_rows, d)
    y = jax.ops.segment_sum(yb * row_w[:, None].astype(yb.dtype), row_tok, num_segments=t + 1)
    return y[:t]


def encoder_layer(x, c, p, lam_init):
    b, s, d = x.shape
    mod = jax.nn.silu(c) @ p['w_ada'] + p['b_ada']
    sh1, sc1, g1, sh2, sc2, g2 = jnp.split(mod, 6, axis=-1)

    h = modulate(rms_norm(x, p['g_norm1']), sh1, sc1)
    proj = h @ p['w_in']
    q, k, v, u = jnp.split(proj, [QK_WIDTH, 2 * QK_WIDTH, 2 * QK_WIDTH + ATTN_WIDTH], axis=-1)
    pos = jnp.arange(s, dtype=jnp.float32)
    q = apply_rotary(rms_norm(q.reshape(b, s, N_HEADS, 2, HEAD_DIM), p['g_q']), pos)
    k = apply_rotary(rms_norm(k.reshape(b, s, N_HEADS, 2, HEAD_DIM), p['g_k']), pos)
    v = v.reshape(b, s, N_HEADS, V_DIM)
    lam = (jnp.exp(jnp.sum(p['lambda_q1'].astype(jnp.float32) * p['lambda_k1'].astype(jnp.float32)))
           - jnp.exp(jnp.sum(p['lambda_q2'].astype(jnp.float32) * p['lambda_k2'].astype(jnp.float32)))
           + lam_init)
    o = diff_attention(q, k, v, lam)
    o = (rms_norm(o, p['g_subln']) * (1.0 - lam_init)).reshape(b, s, ATTN_WIDTH)
    cv = conformer_conv(u, p['w_dw'], p['b_dw'], p['g_conv_ln'], p['b_conv_ln'])
    mix = jnp.concatenate([o, cv], axis=-1) @ p['w_out']
    x = x + g1[:, None, :] * mix

    h2 = modulate(rms_norm(x, p['g_norm2']), sh2, sc2)
    y = hier_moe(h2.reshape(b * s, d), p['w_router_group'], p['b_router_group'],
                 p['w_router_expert'], p['b_router_expert'], p['w_gate_up'], p['w_down'])
    return x + g2[:, None, :] * y.reshape(b, s, d)


def setup_inputs(seed: int = 0) -> dict:
    key = jax.random.key(seed)
    ks = jax.random.split(key, 32)
    L, D = DEPTH, D_MODEL

    def nrm(k, shape, scale):
        return jax.random.normal(k, shape, jnp.float32) * scale

    return {
        'x_prompt': nrm(ks[0], (BATCH, SEQ, D), 1.0),
        'x_sample': nrm(ks[1], (DEC_BATCH, DEC_SEQ, D), 1.0),
        'c_prompt': nrm(ks[2], (BATCH, D), 1.0),
        'c_sample': nrm(ks[3], (DEC_BATCH, D), 1.0),
        'w_ada': nrm(ks[4], (L, D, 6 * D), 0.1 * D ** -0.5),
        'b_ada': nrm(ks[5], (L, 6 * D), 0.01),
        'g_norm1': 1.0 + nrm(ks[6], (L, D), 0.02),
        'w_in': nrm(ks[7], (L, D, IN_WIDTH), D ** -0.5),
        'g_q': 1.0 + nrm(ks[8], (L, HEAD_DIM), 0.02),
        'g_k': 1.0 + nrm(ks[9], (L, HEAD_DIM), 0.02),
        'lambda_q1': nrm(ks[10], (L, HEAD_DIM), 0.1),
        'lambda_k1': nrm(ks[11], (L, HEAD_DIM), 0.1),
        'lambda_q2': nrm(ks[12], (L, HEAD_DIM), 0.1),
        'lambda_k2': nrm(ks[13], (L, HEAD_DIM), 0.1),
        'g_subln': 1.0 + nrm(ks[14], (L, V_DIM), 0.02),
        'w_dw': nrm(ks[15], (L, CONV_KERNEL, CONV_WIDTH), CONV_KERNEL ** -0.5),
        'b_dw': nrm(ks[16], (L, CONV_WIDTH), 0.01),
        'g_conv_ln': 1.0 + nrm(ks[17], (L, CONV_WIDTH), 0.02),
        'b_conv_ln': nrm(ks[18], (L, CONV_WIDTH), 0.01),
        'w_out': nrm(ks[19], (L, D, D), D ** -0.5),
        'g_norm2': 1.0 + nrm(ks[20], (L, D), 0.02),
        'w_router_group': nrm(ks[21], (L, D, N_GROUPS), D ** -0.5),
        'b_router_group': nrm(ks[22], (L, N_GROUPS), 0.01),
        'w_router_expert': nrm(ks[23], (L, D, N_EXPERTS), D ** -0.5),
        'b_router_expert': nrm(ks[24], (L, N_EXPERTS), 0.01),
        'w_gate_up': nrm(ks[25], (L, N_EXPERTS, D, 2 * EXPERT_FF), D ** -0.5),
        'w_down': nrm(ks[26], (L, N_EXPERTS, EXPERT_FF, D), EXPERT_FF ** -0.5),
    }


def reference(x_prompt, x_sample, c_prompt, c_sample, w_ada, b_ada, g_norm1, w_in, g_q, g_k,
              lambda_q1, lambda_k1, lambda_q2, lambda_k2, g_subln, w_dw, b_dw, g_conv_ln, b_conv_ln,
              w_out, g_norm2, w_router_group, b_router_group, w_router_expert, b_router_expert,
              w_gate_up, w_down):
    xp, xs = x_prompt, x_sample
    for l in range(DEPTH):
        lam_init = 0.8 - 0.6 * math.exp(-0.3 * l)
        p = dict(w_ada=w_ada[l], b_ada=b_ada[l], g_norm1=g_norm1[l], w_in=w_in[l], g_q=g_q[l], g_k=g_k[l],
                 lambda_q1=lambda_q1[l], lambda_k1=lambda_k1[l], lambda_q2=lambda_q2[l], lambda_k2=lambda_k2[l],
                 g_subln=g_subln[l], w_dw=w_dw[l], b_dw=b_dw[l], g_conv_ln=g_conv_ln[l], b_conv_ln=b_conv_ln[l],
                 w_out=w_out[l], g_norm2=g_norm2[l], w_router_group=w_router_group[l],
                 b_router_group=b_router_group[l], w_router_expert=w_router_expert[l],
                 b_router_expert=b_router_expert[l], w_gate_up=w_gate_up[l], w_down=w_down[l])
        xp = encoder_layer(xp, c_prompt, p, lam_init)
        xs = encoder_layer(xs, c_sample, p, lam_init)
    return (xp, xs)
```

```cpp
#include <hip/hip_runtime.h>
#include <hip/hip_cooperative_groups.h>
#include <math.h>
#include <string.h>
namespace cg = cooperative_groups;

#ifndef PHMASK
#define PHMASK 0x1ff
#endif
#ifndef PROBE_MASK
#define PROBE_MASK 0
#endif
#ifndef N_LAUNCH_MODE
#define N_LAUNCH_MODE 0
#endif

typedef unsigned short bfr;
using bf16x8 = __attribute__((ext_vector_type(8))) short;
using f32x16 = __attribute__((ext_vector_type(16))) float;
using u32x4 = __attribute__((ext_vector_type(4))) unsigned;
using u32x2 = __attribute__((ext_vector_type(2))) unsigned;
typedef __bf16 bf2_t __attribute__((ext_vector_type(2)));
typedef float fl2_t __attribute__((ext_vector_type(2)));

#define DI __device__ __forceinline__
#define MFMA(a, b, c) __builtin_amdgcn_mfma_f32_32x32x16_bf16((a), (b), (c), 0, 0, 0)

constexpr int D = 1024;
constexpr int TP = 65536, TS = 32768, T = TP + TS;
constexpr int NBR = 18;
constexpr int LDS_BYTES = 155648;
constexpr int NT = 512;
constexpr int VLDS = 65536;
constexpr int NPHASE = 9;

constexpr size_t WS_MOD = 0;
constexpr size_t WS_ROPE = 458752;
constexpr size_t WS_WRT = WS_ROPE + 1048576;
constexpr size_t WS_CNT = WS_WRT + 147456;
constexpr size_t WS_WIN = WS_CNT + 1024;
constexpr size_t WS_WOUT = WS_WIN + 5242880;
constexpr size_t WS_WGU = WS_WOUT + 2097152;
constexpr size_t WS_WD = WS_WGU + 67108864;
constexpr size_t WS_H = WS_WD + 33554432;
constexpr size_t WS_Q = WS_H + (size_t)T * 1024 * 2;
constexpr size_t WS_K = WS_Q + (size_t)T * 512 * 2;
constexpr size_t WS_VT = WS_K + (size_t)T * 512 * 2;
constexpr size_t WS_Z = WS_VT + (size_t)T * 512 * 2;
constexpr size_t WS_ACT = WS_Q;
constexpr size_t WS_LIST = WS_VT;
constexpr size_t WS_GATE = WS_Z;

struct Params {
  const float *xp, *xs, *cp, *cs, *w_ada, *b_ada, *g_norm1, *w_in, *g_q, *g_k, *lq1, *lk1, *lq2, *lk2, *g_subln, *w_dw, *b_dw,
      *g_cln, *b_cln, *w_out, *g_norm2, *w_rg, *b_rg, *w_re, *b_re, *w_gu, *w_d;
  float* out;
  unsigned char* ws;
  double inv_freq[8];
  int ph_lo, ph_hi, dummy, pad_;
};

DI unsigned pk2(float a, float b) { fl2_t f = {a, b}; bf2_t r = __builtin_convertvector(f, bf2_t); return __builtin_bit_cast(unsigned, r); }
DI float wave_sum(float v) {
#pragma unroll
  for (int o = 32; o > 0; o >>= 1) v += __shfl_xor(v, o, 64);
  return v;
}
DI void dma16(const void* src, void* lds_wave_base) { __builtin_amdgcn_global_load_lds((const unsigned*)src, (unsigned*)lds_wave_base, 16, 0, 0); }
DI void wait_vm0() { asm volatile("s_waitcnt vmcnt(0)" ::: "memory"); }
DI bf16x8 frag(const char* img, int row, int chunk) { return *(const bf16x8*)(img + row * 128 + ((chunk ^ ((row >> 1) & 7)) << 4)); }
DI void tok_info(int t, int& br, int& s, int& S) {
  if (t < TP) { br = t >> 12; s = t & 4095; S = 4096; } else { int u = t - TP; br = 16 + (u >> 14); s = u & 16383; S = 16384; }
}
DI const float* xrow(const Params& p, int t) { return t < TP ? p.xp + (size_t)t * D : p.xs + (size_t)(t - TP) * D; }

DI void transpose_tile(const float* __restrict__ src, bfr* __restrict__ dst, int K, int N, int k0, int n0, float* lds, int tid) {
#pragma unroll
  for (int ps = 0; ps < 4; ++ps) {
    int kk = ps * 16 + (tid >> 4), n4 = (tid & 15) * 4;
    float4 v = *(const float4*)(src + (size_t)(k0 + kk) * N + n0 + n4);
    lds[kk * 65 + n4 + 0] = v.x; lds[kk * 65 + n4 + 1] = v.y; lds[kk * 65 + n4 + 2] = v.z; lds[kk * 65 + n4 + 3] = v.w;
  }
  __syncthreads();
#pragma unroll
  for (int ps = 0; ps < 2; ++ps) {
    int nn = ps * 32 + (tid >> 3), kc = (tid & 7) * 8;
    u32x4 o;
    o[0] = pk2(lds[(kc + 0) * 65 + nn], lds[(kc + 1) * 65 + nn]);
    o[1] = pk2(lds[(kc + 2) * 65 + nn], lds[(kc + 3) * 65 + nn]);
    o[2] = pk2(lds[(kc + 4) * 65 + nn], lds[(kc + 5) * 65 + nn]);
    o[3] = pk2(lds[(kc + 6) * 65 + nn], lds[(kc + 7) * 65 + nn]);
    *(u32x4*)(dst + ((size_t)((k0 + kc) >> 5) * N + (n0 + nn)) * 32 + ((k0 + kc) & 31)) = o;
  }
  __syncthreads();
}

DI void phase0(const Params& p, char* lds0) {
  const int vb = threadIdx.x >> 8, tid = threadIdx.x & 255, G = gridDim.x, bid = blockIdx.x;
  char* lds = lds0 + vb * VLDS;
  const int gtid = bid * NT + threadIdx.x, gsz = G * NT;
  unsigned char* ws = p.ws;
  if (bid == 0 && threadIdx.x < 128) ((int*)(ws + WS_CNT))[threadIdx.x] = 0;
  float2* rope = (float2*)(ws + WS_ROPE);
  for (int i = gtid; i < 16384 * 8; i += gsz) {
    int s = i >> 3, f = i & 7;
    double a = (double)s * p.inv_freq[f];
    double n = rint(a * 0.15915494309189535);
    float r = (float)(a - n * 6.283185307179586);
    rope[i] = make_float2(__cosf(r), __sinf(r));
  }
  float* wrt = (float*)(ws + WS_WRT);
  for (int i = gtid; i < 36 * 1024; i += gsz) {
    int n = i >> 10, k = i & 1023;
    wrt[i] = n < 4 ? p.w_rg[k * 4 + n] : p.w_re[k * 32 + (n - 4)];
  }
  float* mod = (float*)(ws + WS_MOD);
  {
    float* sc = (float*)lds;
    float* red = (float*)(lds + 40960);
    const int w = tid >> 6, lane = tid & 63;
    const int mb = G >= 48 ? G - 48 : 0;
    for (int item0 = bid - mb; item0 >= 0 && item0 < 48; item0 += G) {
      const int item = item0 * 2 + vb;
      const int col = item * 64 + lane;
      float acc[NBR];
#pragma unroll
      for (int r = 0; r < NBR; ++r) acc[r] = 0.f;
      for (int kh = 0; kh < 2; ++kh) {
        __syncthreads();
        for (int idx = tid; idx < NBR * 512; idx += 256) {
          int r = idx >> 9, k = idx & 511;
          float c = r < 16 ? p.cp[r * 1024 + kh * 512 + k] : p.cs[(r - 16) * 1024 + kh * 512 + k];
          sc[k * 20 + r] = c / (1.f + __expf(-c));
        }
        __syncthreads();
        for (int i0 = 0; i0 < 128; i0 += 16) {
          float wvv[16];
#pragma unroll
          for (int u = 0; u < 16; ++u) wvv[u] = p.w_ada[(size_t)(kh * 512 + w * 128 + i0 + u) * 6144 + col];
#pragma unroll
          for (int u = 0; u < 16; ++u) {
            const int kl = w * 128 + i0 + u;
            const float wv = wvv[u];
            const float4* s4 = (const float4*)(sc + kl * 20);
            float4 a0 = s4[0], a1 = s4[1], a2 = s4[2], a3 = s4[3];
            float2 a4 = *(const float2*)(sc + kl * 20 + 16);
            acc[0] += a0.x * wv; acc[1] += a0.y * wv; acc[2] += a0.z * wv; acc[3] += a0.w * wv;
            acc[4] += a1.x * wv; acc[5] += a1.y * wv; acc[6] += a1.z * wv; acc[7] += a1.w * wv;
            acc[8] += a2.x * wv; acc[9] += a2.y * wv; acc[10] += a2.z * wv; acc[11] += a2.w * wv;
            acc[12] += a3.x * wv; acc[13] += a3.y * wv; acc[14] += a3.z * wv; acc[15] += a3.w * wv;
            acc[16] += a4.x * wv; acc[17] += a4.y * wv;
          }
        }
      }
      __syncthreads();
#pragma unroll
      for (int r = 0; r < NBR; ++r) red[(w * NBR + r) * 64 + lane] = acc[r];
      __syncthreads();
      for (int idx = tid; idx < NBR * 64; idx += 256) {
        int r = idx >> 6, l = idx & 63;
        float s = red[(0 * NBR + r) * 64 + l] + red[(1 * NBR + r) * 64 + l] + red[(2 * NBR + r) * 64 + l] + red[(3 * NBR + r) * 64 + l];
        mod[r * 6144 + item * 64 + l] = s + p.b_ada[item * 64 + l];
      }
      __syncthreads();
    }
  }
  {
    float* tl = (float*)lds;
    const int n_in = 16 * 40, n_out = 16 * 16, n_gu = 32 * 256, n_d = 32 * 128;
    const int total = n_in + n_out + n_gu + n_d;
    for (int it0 = bid; it0 < total / 2; it0 += G) {
      const int it = it0 * 2 + vb;
      if (it < n_in) {
        int kt = it / 40, nt = it % 40;
        transpose_tile(p.w_in, (bfr*)(ws + WS_WIN), 1024, 2560, kt * 64, nt * 64, tl, tid);
      } else if (it < n_in + n_out) {
        int i2 = it - n_in; int kt = i2 >> 4, nt = i2 & 15;
        transpose_tile(p.w_out, (bfr*)(ws + WS_WOUT), 1024, 1024, kt * 64, nt * 64, tl, tid);
      } else if (it < n_in + n_out + n_gu) {
        int i2 = it - n_in - n_out; int e = i2 >> 8, r = i2 & 255; int kt = r >> 4, nt = r & 15;
        transpose_tile(p.w_gu + (size_t)e * 1024 * 1024, (bfr*)(ws + WS_WGU) + (size_t)e * 1024 * 1024, 1024, 1024, kt * 64, nt * 64, tl, tid);
      } else {
        int i2 = it - n_in - n_out - n_gu; int e = i2 >> 7, r = i2 & 127; int kt = r >> 4, nt = r & 15;
        transpose_tile(p.w_d + (size_t)e * 512 * 1024, (bfr*)(ws + WS_WD) + (size_t)e * 1024 * 512, 512, 1024, kt * 64, nt * 64, tl, tid);
      }
    }
  }
}

DI void phase1(const Params& p) {
  const int tid = threadIdx.x, w = tid >> 6, lane = tid & 63;
  const float* mod = (const float*)(p.ws + WS_MOD);
  bfr* H = (bfr*)(p.ws + WS_H);
  const int nwv = gridDim.x * 8, per = (T + nwv - 1) / nwv;
  const int t_begin = (blockIdx.x * 8 + w) * per, t_end = t_begin + per < T ? t_begin + per : T;
  if (t_begin >= t_end) return;
  float4 nx[4], csv[4], shv[4];
#pragma unroll
  for (int j = 0; j < 4; ++j) nx[j] = *(const float4*)(xrow(p, t_begin) + j * 256 + lane * 4);
  int cur_br = -1;
  for (int t = t_begin; t < t_end; ++t) {
    int br, s, S; tok_info(t, br, s, S);
    if (br != cur_br) {
      cur_br = br;
      const float* sh = mod + br * 6144, *scl = mod + br * 6144 + 1024;
#pragma unroll
      for (int j = 0; j < 4; ++j) {
        const int c = j * 256 + lane * 4;
        float4 g = *(const float4*)(p.g_norm1 + c), a = *(const float4*)(scl + c);
        csv[j] = make_float4(g.x * (1.f + a.x), g.y * (1.f + a.y), g.z * (1.f + a.z), g.w * (1.f + a.w));
        shv[j] = *(const float4*)(sh + c);
      }
    }
    float4 v[4];
#pragma unroll
    for (int j = 0; j < 4; ++j) v[j] = nx[j];
    if (t + 1 < t_end) {
      const float* x1 = xrow(p, t + 1);
#pragma unroll
      for (int j = 0; j < 4; ++j) nx[j] = *(const float4*)(x1 + j * 256 + lane * 4);
    }
    float ss = 0.f;
#pragma unroll
    for (int j = 0; j < 4; ++j) ss += v[j].x * v[j].x + v[j].y * v[j].y + v[j].z * v[j].z + v[j].w * v[j].w;
    ss = wave_sum(ss);
    const float rstd = rsqrtf(ss * (1.f / 1024.f) + 1e-6f);
#pragma unroll
    for (int j = 0; j < 4; ++j) {
      const int c = j * 256 + lane * 4;
      float o0 = v[j].x * rstd * csv[j].x + shv[j].x, o1 = v[j].y * rstd * csv[j].y + shv[j].y;
      float o2 = v[j].z * rstd * csv[j].z + shv[j].z, o3 = v[j].w * rstd * csv[j].w + shv[j].w;
      u32x2 o; o[0] = pk2(o0, o1); o[1] = pk2(o2, o3);
      *(u32x2*)(H + (size_t)t * D + c) = o;
    }
  }
}

constexpr int CSS = 264;
DI float bf2f(bfr v) { return __uint_as_float((unsigned)v << 16); }
DI float4 cs4(const bfr* Cs, int row, int col) {
  const u32x2 u = *(const u32x2*)(Cs + row * CSS + col);
  return make_float4(__uint_as_float(u[0] << 16), __uint_as_float(u[0] & 0xffff0000u), __uint_as_float(u[1] << 16), __uint_as_float(u[1] & 0xffff0000u));
}
#define WAIT_V(n) asm volatile("s_waitcnt vmcnt(%0)" ::"n"(n) : "memory")
#define RAW_BARRIER() do { asm volatile("s_waitcnt lgkmcnt(0)" ::: "memory"); __builtin_amdgcn_s_barrier(); } while (0)
template <typename FA, typename FB, typename FE>
DI void gemm_tile(char* lds, int K, int astride, int bstride, FA arow, FB brow, FE epi) {
  const int tid = threadIdx.x, w = __builtin_amdgcn_readfirstlane(tid >> 6), lane = tid & 63, r = lane & 31, h8 = lane >> 5;
  const int wm = w >> 1, wn = w & 1;
  const bfr* ap[2]; const bfr* bp[2];
#pragma unroll
  for (int i = 0; i < 2; ++i) {
    const int row = (w * 2 + i) * 16 + (lane >> 2);
    const int sw = ((lane & 3) ^ ((row >> 2) & 3)) * 8;
    ap[i] = arow(row) + sw;
    bp[i] = brow(row) + sw;
  }
  int foff[2];
#pragma unroll
  for (int ks = 0; ks < 2; ++ks) foff[ks] = r * 64 + (((ks * 2 + h8) ^ ((r >> 2) & 3)) << 4);
  f32x16 acc[2][4];
#pragma unroll
  for (int a = 0; a < 2; ++a)
#pragma unroll
    for (int b = 0; b < 4; ++b)
#pragma unroll
      for (int i = 0; i < 16; ++i) acc[a][b][i] = 0.f;
  const int nk = K >> 5;
  auto stage = [&](int buf, int kt) {
    char* sa = lds + buf * 32768;
#pragma unroll
    for (int i = 0; i < 2; ++i) {
      dma16(ap[i] + (size_t)kt * astride, sa + (w * 2 + i) * 1024);
      dma16(bp[i] + (size_t)kt * bstride, sa + 16384 + (w * 2 + i) * 1024);
    }
  };
  stage(0, 0); stage(1, 1); stage(2, 2);
  for (int kt = 0; kt < nk; ++kt) {
    if (kt + 2 < nk) WAIT_V(8); else if (kt + 1 < nk) WAIT_V(4); else WAIT_V(0);
    RAW_BARRIER();
    if (kt + 3 < nk) stage((kt + 3) & 3, kt + 3);
    const char* sa = lds + (kt & 3) * 32768 + wm * 4096;
    const char* sb = lds + (kt & 3) * 32768 + 16384 + wn * 8192;
#pragma unroll
    for (int ks = 0; ks < 2; ++ks) {
      bf16x8 a0 = *(const bf16x8*)(sa + foff[ks]), a1 = *(const bf16x8*)(sa + 2048 + foff[ks]);
#pragma unroll
      for (int nt = 0; nt < 4; ++nt) {
        bf16x8 bb = *(const bf16x8*)(sb + nt * 2048 + foff[ks]);
        acc[0][nt] = MFMA(a0, bb, acc[0][nt]);
        acc[1][nt] = MFMA(a1, bb, acc[1][nt]);
      }
    }
  }
  RAW_BARRIER();
  bfr* Cs = (bfr*)lds;
#pragma unroll
  for (int mt = 0; mt < 2; ++mt)
#pragma unroll
    for (int nt = 0; nt < 4; ++nt)
#pragma unroll
      for (int i = 0; i < 16; i += 2) {
        const int row = wm * 64 + mt * 32 + (i & 3) + 8 * (i >> 2) + 4 * h8;
        const unsigned pr = pk2(acc[mt][nt][i], acc[mt][nt][i + 1]);
        Cs[row * CSS + wn * 128 + nt * 32 + r] = (bfr)(pr & 0xffffu);
        Cs[(row + 1) * CSS + wn * 128 + nt * 32 + r] = (bfr)(pr >> 16);
      }
  __syncthreads();
  {
    const int vb = tid >> 8, vtid = tid & 255;
    epi(vb, 0, vtid);
    epi(vb, 1, vtid);
  }
  __syncthreads();
}

struct XSched {
  int xcd, slot, nslot, nmaj_x, nminor, j, total;
  DI void init(int nmajor, int nminor_) {
    const int G = gridDim.x, b = blockIdx.x;
    if (G % 8 == 0) { xcd = b & 7; slot = b >> 3; nslot = G >> 3; nmaj_x = (nmajor - xcd + 7) >> 3; }
    else { xcd = 0; slot = b; nslot = G; nmaj_x = nmajor; }
    nminor = nminor_; j = slot; total = nmaj_x * nminor;
  }
  DI bool next(int& major, int& minor) {
    if (j >= total) return false;
    const int mj = j / nminor; minor = j - mj * nminor;
    major = (gridDim.x % 8 == 0) ? xcd + 8 * mj : mj;
    j += nslot;
    return true;
  }
};

DI void phase2(const Params& p, char* lds) {
  unsigned char* ws = p.ws;
  const bfr* H = (const bfr*)(ws + WS_H);
  const bfr* Wt = (const bfr*)(ws + WS_WIN);
  const bfr* Cs0 = (const bfr*)lds;
  const float2* rope = (const float2*)(ws + WS_ROPE);
  const float qscale = 0.125f * 1.4426950408889634f;
  XSched xs; xs.init(384, 10);
  int mt, nt2;
  while (xs.next(mt, nt2)) {
    const int t0 = mt * 256;
    int br, s0f, S; tok_info(t0, br, s0f, S);
    const int bl = t0 < TP ? br : br - 16;
    const size_t gbase = t0 < TP ? 0 : (size_t)TP * 512;
    auto arow = [&](int row) { return H + (size_t)(t0 + row) * D; };
    auto brow = [&](int row256) {
      const int nt = nt2 * 2 + (row256 >> 7), row = row256 & 127;
      int n;
      if (nt < 12) n = nt * 128 + row; else { int j = nt - 12; n = row < 64 ? 1536 + j * 64 + row : 2048 + j * 64 + (row - 64); }
      return Wt + (size_t)n * 32;
    };
    auto epi = [&](int half, int ch, int tid) {
    const int nt = nt2 * 2 + ch;
    const bfr* Cs = Cs0 + half * 128 * CSS + ch * 128;
    const int s0 = s0f + half * 128, t0h = t0 + half * 128;
    if (nt < 8) {
      const bool isK = nt >= 4;
      const int row = tid & 127, hmi = tid >> 7, hm = (nt & 3) * 2 + hmi;
      const float* gsrc = isK ? p.g_k : p.g_q;
      float v[64];
      float ss = 0.f;
#pragma unroll
      for (int j = 0; j < 16; ++j) {
        float4 c4 = cs4(Cs, row, hmi * 64 + j * 4);
        v[j * 4 + 0] = c4.x; v[j * 4 + 1] = c4.y; v[j * 4 + 2] = c4.z; v[j * 4 + 3] = c4.w;
        ss += c4.x * c4.x + c4.y * c4.y + c4.z * c4.z + c4.w * c4.w;
      }
      const float rstd = rsqrtf(ss * (1.f / 64.f) + 1e-6f);
#pragma unroll
      for (int j = 0; j < 16; ++j) {
        float4 g = *(const float4*)(gsrc + j * 4);
        v[j * 4 + 0] *= rstd * g.x; v[j * 4 + 1] *= rstd * g.y; v[j * 4 + 2] *= rstd * g.z; v[j * 4 + 3] *= rstd * g.w;
      }
      const int s = s0 + row;
#pragma unroll
      for (int i = 0; i < 8; ++i) {
        float2 cs = rope[s * 8 + i];
        float x1 = v[i], x2 = v[i + 8];
        v[i] = x1 * cs.x - x2 * cs.y;
        v[i + 8] = x2 * cs.x + x1 * cs.y;
      }
      const float sc = isK ? 1.f : qscale;
      bfr* dst = (bfr*)(ws + (isK ? WS_K : WS_Q)) + gbase + ((size_t)(bl * 8 + hm) * S + s) * 64;
#pragma unroll
      for (int j = 0; j < 8; ++j) {
        u32x4 o;
        o[0] = pk2(v[j * 8 + 0] * sc, v[j * 8 + 1] * sc); o[1] = pk2(v[j * 8 + 2] * sc, v[j * 8 + 3] * sc);
        o[2] = pk2(v[j * 8 + 4] * sc, v[j * 8 + 5] * sc); o[3] = pk2(v[j * 8 + 6] * sc, v[j * 8 + 7] * sc);
        *(u32x4*)(dst + j * 8) = o;
      }
    } else if (nt < 12) {
      const int h = nt - 8, e = tid & 127, tg = tid >> 7;
      bfr* vb = (bfr*)(ws + WS_VT) + gbase + (size_t)(bl * 4 + h) * 128 * S;
#pragma unroll
      for (int g = 0; g < 4; ++g) {
        float v[16];
#pragma unroll
        for (int q = 0; q < 16; ++q) {
          const int key = 8 * ((q >> 2) & 1) + 4 * (q >> 3) + (q & 3);
          v[q] = bf2f(Cs[(tg * 64 + g * 16 + key) * CSS + e]);
        }
        u32x4 o0, o1;
        o0[0] = pk2(v[0], v[1]); o0[1] = pk2(v[2], v[3]); o0[2] = pk2(v[4], v[5]); o0[3] = pk2(v[6], v[7]);
        o1[0] = pk2(v[8], v[9]); o1[1] = pk2(v[10], v[11]); o1[2] = pk2(v[12], v[13]); o1[3] = pk2(v[14], v[15]);
        const int sk = s0 + tg * 64 + g * 16;
        bfr* dst = vb + ((size_t)(sk >> 5) * 128 + e) * 32 + (sk & 16);
        *(u32x4*)(dst) = o0;
        *(u32x4*)(dst + 8) = o1;
      }
    } else {
      const int j = nt - 12, row = tid & 127, hf = tid >> 7;
      bfr* dst = (bfr*)(ws + WS_Z) + (size_t)(t0h + row) * 512 + j * 64 + hf * 32;
#pragma unroll
      for (int q = 0; q < 4; ++q) {
        float z[8];
#pragma unroll
        for (int u = 0; u < 2; ++u) {
          float4 a = cs4(Cs, row, hf * 32 + q * 8 + u * 4);
          float4 g = cs4(Cs, row, 64 + hf * 32 + q * 8 + u * 4);
          z[u * 4 + 0] = a.x / (1.f + __expf(-g.x)); z[u * 4 + 1] = a.y / (1.f + __expf(-g.y));
          z[u * 4 + 2] = a.z / (1.f + __expf(-g.z)); z[u * 4 + 3] = a.w / (1.f + __expf(-g.w));
        }
        u32x4 o; o[0] = pk2(z[0], z[1]); o[1] = pk2(z[2], z[3]); o[2] = pk2(z[4], z[5]); o[3] = pk2(z[6], z[7]);
        *(u32x4*)(dst + q * 8) = o;
      }
    }
    };
    gemm_tile(lds, 1024, 32, 2560 * 32, arow, brow, epi);
  }
}

DI void attn_item(const Params& p, char* lds, int S, const bfr* Qb, const bfr* Kb, const bfr* Vtb, int h, int q0, int tok0) {
  const int tid = threadIdx.x, w = __builtin_amdgcn_readfirstlane(tid >> 6), lane = tid & 63, r = lane & 31, h8 = lane >> 5;
  const int c = w & 1, qg = w >> 1;
  f32x16 O[2][4];
#pragma unroll
  for (int t = 0; t < 2; ++t)
#pragma unroll
    for (int e = 0; e < 4; ++e)
#pragma unroll
      for (int i = 0; i < 16; ++i) O[t][e][i] = 0.f;
  float m[2] = {-64.f, -64.f}, l[2] = {0.f, 0.f};
  const int nkt = S >> 5;
  int voffK[4];
#pragma unroll
  for (int ks = 0; ks < 4; ++ks) voffK[ks] = r * 128 + (((ks * 2 + h8) ^ ((r >> 1) & 7)) << 4);
  const int voffV0 = r * 64 + ((h8 ^ ((r >> 2) & 3)) << 4);
  const int lr = lane >> 3, sl = lane & 7;
  const char* k0p = (const char*)(Kb + (size_t)(h * 2) * S * 64);
  const char* k1p = (const char*)(Kb + (size_t)(h * 2 + 1) * S * 64);
  const char* vtp = (const char*)Vtb;
  unsigned ko, vo;
  { const int row = (w & 3) * 8 + lr; ko = (unsigned)(row * 128 + ((sl ^ ((row >> 1) & 7)) << 4)); }
  { const int row = w * 16 + (lane >> 2); vo = (unsigned)(row * 64 + (((lane & 3) ^ ((row >> 2) & 3)) << 4)); }
  const char* kxp = w < 4 ? k0p : k1p;
  auto stage = [&](int buf, int kt) {
    char* sb = lds + 65536 + buf * 16384;
    dma16(kxp + (size_t)kt * 4096 + ko, sb + w * 1024);
    dma16(vtp + (size_t)kt * 8192 + vo, sb + 8192 + w * 1024);
  };
  __syncthreads();
  {
    const char* qp = (const char*)(Qb + ((size_t)(h * 2 + c) * S + q0 + qg * 64) * 64);
    int lq = threadIdx.x & 63;
    asm volatile("" : "+v"(lq));
    const int lrq = lq >> 3, slq = lq & 7;
#pragma unroll
    for (int i = 0; i < 8; ++i) {
      const int row = i * 8 + lrq;
      dma16(qp + row * 128 + ((slq ^ ((row >> 1) & 7)) << 4), lds + w * 8192 + i * 1024);
    }
  }
  stage(0, 0); stage(1, 1); stage(2, 2);
  const char* qimg = lds + w * 8192;
#pragma unroll 8
  for (int kt = 0; kt < nkt; ++kt) {
    if (kt + 2 < nkt) WAIT_V(4); else if (kt + 1 < nkt) WAIT_V(2); else WAIT_V(0);
    RAW_BARRIER();
    if (kt + 3 < nkt) stage((kt + 3) & 3, kt + 3);
    const char* sb = lds + 65536 + (kt & 3) * 16384;
    const char* kimg = sb + c * 4096;
    const char* vimg = sb + 8192;
    f32x16 st[2];
    {
      bf16x8 kf[4];
#pragma unroll
      for (int ks = 0; ks < 4; ++ks) kf[ks] = *(const bf16x8*)(kimg + voffK[ks]);
#pragma unroll
      for (int t = 0; t < 2; ++t) {
        const float negm = -m[t];
#pragma unroll
        for (int i = 0; i < 16; ++i) st[t][i] = negm;
#pragma unroll
        for (int ks = 0; ks < 4; ++ks) st[t] = MFMA(kf[ks], *(const bf16x8*)(qimg + t * 4096 + voffK[ks]), st[t]);
      }
    }
#pragma unroll
    for (int t = 0; t < 2; ++t) {
      float mx = st[t][0];
#pragma unroll
      for (int i = 1; i < 16; ++i) mx = fmaxf(mx, st[t][i]);
      mx = fmaxf(mx, __shfl_xor(mx, 32, 64));
      if (__any(mx > 6.f)) {
        const float d = fmaxf(mx, 0.f);
        const float alpha = __builtin_amdgcn_exp2f(-d);
        m[t] += d;
        l[t] *= alpha;
#pragma unroll
        for (int i = 0; i < 16; ++i) st[t][i] -= d;
#pragma unroll
        for (int e = 0; e < 4; ++e)
#pragma unroll
          for (int i = 0; i < 16; ++i) O[t][e][i] *= alpha;
      }
    }
    __builtin_amdgcn_iglp_opt(0);
#pragma unroll
    for (int t = 0; t < 2; ++t) {
      float rs = 0.f;
#pragma unroll
      for (int i = 0; i < 16; ++i) { float pv = __builtin_amdgcn_exp2f(st[t][i]); st[t][i] = pv; rs += pv; }
      l[t] += rs;
      bf16x8 pf[2];
#pragma unroll
      for (int kc = 0; kc < 2; ++kc) {
        u32x4 pp;
        pp[0] = pk2(st[t][kc * 8 + 0], st[t][kc * 8 + 1]); pp[1] = pk2(st[t][kc * 8 + 2], st[t][kc * 8 + 3]);
        pp[2] = pk2(st[t][kc * 8 + 4], st[t][kc * 8 + 5]); pp[3] = pk2(st[t][kc * 8 + 6], st[t][kc * 8 + 7]);
        pf[kc] = __builtin_bit_cast(bf16x8, pp);
      }
      asm volatile("" ::: "memory");
#pragma unroll
      for (int e = 0; e < 4; ++e)
#pragma unroll
        for (int kc = 0; kc < 2; ++kc) O[t][e] = MFMA(*(const bf16x8*)(vimg + e * 2048 + (voffV0 ^ (kc << 5))), pf[kc], O[t][e]);
    }
  }
  __syncthreads();
  int tid_e = threadIdx.x;
  asm volatile("" : "+v"(tid_e));
  const int lane_e = tid_e & 63, w_e = __builtin_amdgcn_readfirstlane(tid_e >> 6), r_e = lane_e & 31, h8_e = lane_e >> 5, c_e = w_e & 1, qg_e = w_e >> 1;
  float lam;
  {
    float a = p.lq1[lane_e] * p.lk1[lane_e], b = p.lq2[lane_e] * p.lk2[lane_e];
    a = wave_sum(a); b = wave_sum(b);
    lam = __expf(a) - __expf(b) + 0.2f;
  }
  float* xch = (float*)lds;
#pragma unroll
  for (int t = 0; t < 2; ++t) {
    const float lt = l[t] + __shfl_xor(l[t], 32, 64);
    if (c_e == 1) {
      const float inv1 = lam / lt;
#pragma unroll
      for (int e = 0; e < 4; ++e)
#pragma unroll
        for (int i = 0; i < 16; ++i) xch[((qg_e * 2 + t) * 64 + e * 16 + i) * 64 + lane_e] = O[t][e][i] * inv1;
    } else {
      const float inv0 = 1.f / lt;
#pragma unroll
      for (int e = 0; e < 4; ++e)
#pragma unroll
        for (int i = 0; i < 16; ++i) O[t][e][i] *= inv0;
    }
  }
  __syncthreads();
  if (c_e == 0) {
#pragma unroll
    for (int t = 0; t < 2; ++t) {
      float ss = 0.f;
#pragma unroll
      for (int e = 0; e < 4; ++e)
#pragma unroll
        for (int i = 0; i < 16; ++i) { float o = O[t][e][i] - xch[((qg_e * 2 + t) * 64 + e * 16 + i) * 64 + lane_e]; O[t][e][i] = o; ss += o * o; }
      ss += __shfl_xor(ss, 32, 64);
      const float rstd = rsqrtf(ss * (1.f / 128.f) + 1e-6f) * 0.8f;
      bfr* dst = (bfr*)(p.ws + WS_H) + (size_t)(tok0 + q0 + qg_e * 64 + t * 32 + r_e) * D + h * 128;
#pragma unroll
      for (int e = 0; e < 4; ++e)
#pragma unroll
        for (int g = 0; g < 4; ++g) {
          const int e0 = e * 32 + 8 * g + 4 * h8_e;
          float4 gs = *(const float4*)(p.g_subln + e0);
          u32x2 o;
          o[0] = pk2(O[t][e][4 * g + 0] * rstd * gs.x, O[t][e][4 * g + 1] * rstd * gs.y);
          o[1] = pk2(O[t][e][4 * g + 2] * rstd * gs.z, O[t][e][4 * g + 3] * rstd * gs.w);
          *(u32x2*)(dst + e0) = o;
        }
    }
  }
  __syncthreads();
}

DI void conv_item(const Params& p, char* lds, int t0, int tid) {
  const int w = tid >> 6, lane = tid & 63;
  int br, s0, S; tok_info(t0, br, s0, S);
  const bfr* Z = (const bfr*)(p.ws + WS_Z);
  unsigned* zl = (unsigned*)lds;
  float* red = (float*)(lds + 63488);
  __syncthreads();
  for (int idx = tid; idx < 62 * 64; idx += 256) {
    const int row = idx >> 6, c16 = idx & 63;
    const int s = s0 - 15 + row;
    u32x4 v = {0u, 0u, 0u, 0u};
    if (s >= 0 && s < S) v = *(const u32x4*)(Z + (size_t)(t0 - 15 + row) * 512 + c16 * 8);
    *(u32x4*)(zl + row * 256 + c16 * 4) = v;
  }
  float wa[31], wb[31];
#pragma unroll
  for (int j = 0; j < 31; ++j) { float2 ww = *(const float2*)(p.w_dw + j * 512 + tid * 2); wa[j] = ww.x; wb[j] = ww.y; }
  const float2 bias = *(const float2*)(p.b_dw + tid * 2);
  __syncthreads();
  const float2 gl = *(const float2*)(p.g_cln + tid * 2), bl = *(const float2*)(p.b_cln + tid * 2);
  unsigned* Hu = (unsigned*)(p.ws + WS_H);
#pragma unroll 1
  for (int ps = 0; ps < 4; ++ps) {
    float za[38], zb[38];
#pragma unroll
    for (int rr = 0; rr < 38; ++rr) {
      const unsigned u = zl[(ps * 8 + rr) * 256 + tid];
      za[rr] = __uint_as_float(u << 16); zb[rr] = __uint_as_float(u & 0xffff0000u);
    }
    float ya[8], yb[8];
#pragma unroll
    for (int i = 0; i < 8; ++i) {
      float a = bias.x, b = bias.y;
#pragma unroll
      for (int j = 0; j < 31; ++j) { a += wa[j] * za[i + j]; b += wb[j] * zb[i + j]; }
      ya[i] = a; yb[i] = b;
    }
#pragma unroll
    for (int i = 0; i < 8; ++i) {
      float s1 = wave_sum(ya[i] + yb[i]);
      float s2 = wave_sum(ya[i] * ya[i] + yb[i] * yb[i]);
      if (lane == 0) { red[(w * 8 + i) * 2] = s1; red[(w * 8 + i) * 2 + 1] = s2; }
    }
    __syncthreads();
#pragma unroll
    for (int i = 0; i < 8; ++i) {
      const float s1 = red[(0 * 8 + i) * 2] + red[(1 * 8 + i) * 2] + red[(2 * 8 + i) * 2] + red[(3 * 8 + i) * 2];
      const float s2 = red[(0 * 8 + i) * 2 + 1] + red[(1 * 8 + i) * 2 + 1] + red[(2 * 8 + i) * 2 + 1] + red[(3 * 8 + i) * 2 + 1];
      const float mu = s1 * (1.f / 512.f);
      const float var = fmaxf(s2 * (1.f / 512.f) - mu * mu, 0.f);
      const float rstd = rsqrtf(var + 1e-6f);
      float a = (ya[i] - mu) * rstd * gl.x + bl.x, b = (yb[i] - mu) * rstd * gl.y + bl.y;
      a = a / (1.f + __expf(-a)); b = b / (1.f + __expf(-b));
      Hu[((size_t)(t0 + ps * 8 + i) * D + 512) / 2 + tid] = pk2(a, b);
    }
    __syncthreads();
  }
}

DI void phase3(const Params& p, char* lds) {
  const int n_s = 512, n_p = 1024, n_c = T / 32;
  for (int it = blockIdx.x; it < n_s + n_p; it += gridDim.x) {
    int S, b, h, qt, tok0; size_t gb;
    if (it < n_s) {
      const int bh = it & 7; qt = it >> 3; b = bh >> 2; h = bh & 3; S = 16384;
      gb = (size_t)TP * 512 + (size_t)b * 16384 * 512; tok0 = TP + b * 16384;
    } else {
      const int i2 = it - n_s, x = i2 & 7, y = i2 >> 3;
      const int bh = x + 8 * (y >> 4); qt = y & 15; b = bh >> 2; h = bh & 3; S = 4096;
      gb = (size_t)b * 4096 * 512; tok0 = b * 4096;
    }
    unsigned char* ws = p.ws;
    asm volatile("" : "+s"(ws));
    const bfr* Qg = (const bfr*)(ws + WS_Q);
    const bfr* Kg = (const bfr*)(ws + WS_K);
    const bfr* Vg = (const bfr*)(ws + WS_VT);
    attn_item(p, lds, S, Qg + gb, Kg + gb, Vg + gb + (size_t)h * 128 * S, h, qt * 256, tok0);
  }
  {
    const int vb = threadIdx.x >> 8, vtid = threadIdx.x & 255;
    for (int it0 = blockIdx.x; it0 < n_c / 2; it0 += gridDim.x) conv_item(p, lds + vb * VLDS, (it0 * 2 + vb) * 32, vtid);
  }
}

DI void phase4(const Params& p, char* lds) {
  const bfr* H = (const bfr*)(p.ws + WS_H);
  const bfr* Wt = (const bfr*)(p.ws + WS_WOUT);
  const float* mod = (const float*)(p.ws + WS_MOD);
  const bfr* Cs0 = (const bfr*)lds;
  XSched xs; xs.init(384, 4);
  int mt, nt2;
  while (xs.next(mt, nt2)) {
    const int t0 = mt * 256;
    int br, s0, S; tok_info(t0, br, s0, S);
    auto arow = [&](int row) { return H + (size_t)(t0 + row) * D; };
    auto brow = [&](int row) { return Wt + (size_t)(nt2 * 256 + row) * 32; };
    auto epi = [&](int half, int ch, int tid) {
      const bfr* Cs = Cs0 + half * 128 * CSS + ch * 128;
      const int c4 = (tid & 31) * 4, col = nt2 * 256 + ch * 128 + c4, t0h = t0 + half * 128;
      const float4 g1 = *(const float4*)(mod + br * 6144 + 2 * 1024 + col);
      float4 xv[16];
#pragma unroll
      for (int ps = 0; ps < 16; ++ps) xv[ps] = *(const float4*)(xrow(p, t0h + ps * 8 + (tid >> 5)) + col);
      asm volatile("" ::: "memory");
#pragma unroll
      for (int ps = 0; ps < 16; ++ps) {
        const int row = ps * 8 + (tid >> 5), t = t0h + row;
        float4 c = cs4(Cs, row, c4);
        float4 o = make_float4(xv[ps].x + g1.x * c.x, xv[ps].y + g1.y * c.y, xv[ps].z + g1.z * c.z, xv[ps].w + g1.w * c.w);
        *(float4*)(p.out + (size_t)t * D + col) = o;
      }
    };
    gemm_tile(lds, 1024, 32, 1024 * 32, arow, brow, epi);
  }
}

DI void phase5(const Params& p, char* lds0) {
  const int vb = threadIdx.x >> 8, tid = threadIdx.x & 255, w = tid >> 6, lane = tid & 63;
  char* lds = lds0 + vb * 4096;
  const float* mod = (const float*)(p.ws + WS_MOD);
  const float* wrt = (const float*)(p.ws + WS_WRT);
  bfr* H = (bfr*)(p.ws + WS_H);
  int* cnt = (int*)(p.ws + WS_CNT) + p.dummy * 64;
  int* list = (int*)(p.ws + WS_LIST) + (size_t)p.dummy * 8388608;
  float* gate = (float*)(p.ws + WS_GATE);
  int* hist = (int*)lds;
  int* base = hist + 64;
  int* info = base + 64;
  float* wg = (float*)(lds0 + 8192);
  __syncthreads();
  for (int i = threadIdx.x; i < 36 * 256; i += NT) *(float4*)(wg + i * 4) = *(const float4*)(wrt + i * 4);
  __syncthreads();
  for (int chunk0 = blockIdx.x; chunk0 < T / 128; chunk0 += gridDim.x) {
    const int chunk = chunk0 * 2 + vb;
    __syncthreads();
    if (tid < 64) hist[tid] = 0;
    __syncthreads();
    const int hw = lane >> 5, l32 = lane & 31;
    float4 csv[8], shv[8];
    {
      int brc, sc_, Sc_; tok_info(chunk * 64, brc, sc_, Sc_);
      const float* shp = mod + brc * 6144 + 3 * 1024, *sclp = mod + brc * 6144 + 4 * 1024;
#pragma unroll
      for (int j = 0; j < 8; ++j) {
        const int c = j * 128 + l32 * 4;
        float4 g = *(const float4*)(p.g_norm2 + c), a = *(const float4*)(sclp + c);
        csv[j] = make_float4(g.x * (1.f + a.x), g.y * (1.f + a.y), g.z * (1.f + a.z), g.w * (1.f + a.w));
        shv[j] = *(const float4*)(shp + c);
      }
    }
    float4 nx[8];
    {
      const float* x0 = p.out + (size_t)(chunk * 64 + w * 16 + hw) * D;
#pragma unroll
      for (int j = 0; j < 8; ++j) nx[j] = *(const float4*)(x0 + j * 128 + l32 * 4);
    }
    for (int i = 0; i < 8; ++i) {
      const int tl = w * 16 + i * 2 + hw, t = chunk * 64 + tl;
      int br, s, S; tok_info(t, br, s, S);
      float hv[32];
      float ss = 0.f;
#pragma unroll
      for (int j = 0; j < 8; ++j) {
        float4 v = nx[j];
        hv[j * 4 + 0] = v.x; hv[j * 4 + 1] = v.y; hv[j * 4 + 2] = v.z; hv[j * 4 + 3] = v.w;
        ss += v.x * v.x + v.y * v.y + v.z * v.z + v.w * v.w;
      }
      if (i + 1 < 8) {
        const float* x1 = p.out + (size_t)(t + 2) * D;
#pragma unroll
        for (int j = 0; j < 8; ++j) nx[j] = *(const float4*)(x1 + j * 128 + l32 * 4);
      }
#define HSUM(v) do { v += __shfl_xor(v, 16, 64); v += __shfl_xor(v, 8, 64); v += __shfl_xor(v, 4, 64); v += __shfl_xor(v, 2, 64); v += __shfl_xor(v, 1, 64); } while (0)
      HSUM(ss);
      const float rstd = rsqrtf(ss * (1.f / 1024.f) + 1e-6f);
#pragma unroll
      for (int j = 0; j < 8; ++j) {
        const int c = j * 128 + l32 * 4;
        hv[j * 4 + 0] = hv[j * 4 + 0] * rstd * csv[j].x + shv[j].x;
        hv[j * 4 + 1] = hv[j * 4 + 1] * rstd * csv[j].y + shv[j].y;
        hv[j * 4 + 2] = hv[j * 4 + 2] * rstd * csv[j].z + shv[j].z;
        hv[j * 4 + 3] = hv[j * 4 + 3] * rstd * csv[j].w + shv[j].w;
        u32x2 o; o[0] = pk2(hv[j * 4 + 0], hv[j * 4 + 1]); o[1] = pk2(hv[j * 4 + 2], hv[j * 4 + 3]);
        *(u32x2*)(H + (size_t)t * D + c) = o;
      }
      float lg[4];
#pragma unroll
      for (int n = 0; n < 4; ++n) {
        float a = 0.f;
#pragma unroll
        for (int j = 0; j < 8; ++j) {
          float4 wv = *(const float4*)(wg + n * 1024 + j * 128 + l32 * 4);
          a += hv[j * 4 + 0] * wv.x + hv[j * 4 + 1] * wv.y + hv[j * 4 + 2] * wv.z + hv[j * 4 + 3] * wv.w;
        }
        HSUM(a);
        lg[n] = a + p.b_rg[n];
      }
      int g = 0; float gm = lg[0];
#pragma unroll
      for (int n = 1; n < 4; ++n) if (lg[n] > gm) { gm = lg[n]; g = n; }
      float den = 0.f;
#pragma unroll
      for (int n = 0; n < 4; ++n) den += __expf(lg[n] - gm);
      const float pgrp = 1.f / den;
      float le[8];
#pragma unroll
      for (int e = 0; e < 8; ++e) {
        const float* wr = wg + (4 + g * 8 + e) * 1024;
        float a = 0.f;
#pragma unroll
        for (int j = 0; j < 8; ++j) {
          float4 wv = *(const float4*)(wr + j * 128 + l32 * 4);
          a += hv[j * 4 + 0] * wv.x + hv[j * 4 + 1] * wv.y + hv[j * 4 + 2] * wv.z + hv[j * 4 + 3] * wv.w;
        }
        HSUM(a);
        le[e] = a + p.b_re[g * 8 + e];
      }
#undef HSUM
      int i1 = 0; float v1 = le[0];
#pragma unroll
      for (int e = 1; e < 8; ++e) if (le[e] > v1) { v1 = le[e]; i1 = e; }
      int i2 = -1; float v2 = -3.0e38f;
#pragma unroll
      for (int e = 0; e < 8; ++e) if (e != i1 && le[e] > v2) { v2 = le[e]; i2 = e; }
      const float e2 = __expf(v2 - v1);
      const float w1 = pgrp / (1.f + e2), w2 = pgrp * e2 / (1.f + e2);
      if (l32 == 0) {
        const int li0 = (g * 8 + i1) * 2, li1 = (g * 8 + i2) * 2 + 1;
        const int lp0 = atomicAdd(&hist[li0], 1), lp1 = atomicAdd(&hist[li1], 1);
        info[tl * 4 + 0] = li0; info[tl * 4 + 1] = li1; info[tl * 4 + 2] = lp0; info[tl * 4 + 3] = lp1;
        gate[t] = w1; gate[T + t] = w2;
      }
    }
    __syncthreads();
    if (tid < 64) { const int hcnt = hist[tid]; base[tid] = hcnt ? atomicAdd(&cnt[tid], hcnt) : 0; }
    __syncthreads();
    if (tid < 64) {
      const int t = chunk * 64 + tid;
      const int li0 = info[tid * 4 + 0], li1 = info[tid * 4 + 1];
      list[(size_t)li0 * T + base[li0] + info[tid * 4 + 2]] = t;
      list[(size_t)li1 * T + base[li1] + info[tid * 4 + 3]] = t;
    }
  }
  __syncthreads();
}

DI void phase_moe(const Params& p, char* lds, int mode) {
  const int tid = threadIdx.x;
  unsigned char* ws = p.ws;
  const int* cnt = (const int*)(ws + WS_CNT);
  const int* list = (const int*)(ws + WS_LIST);
  const bfr* H = (const bfr*)(ws + WS_H);
  bfr* act = (bfr*)(ws + WS_ACT);
  const float* gate = (const float*)(ws + WS_GATE);
  const float* mod = (const float*)(ws + WS_MOD);
  const bfr* Cs0 = (const bfr*)lds;
  int* pre = (int*)(lds + 135168);
  int* rowtok = pre + 72;
  float* g2t = (float*)(lds + 136704);
  int* lb = (int*)(lds + 155136);
  const int nl = mode == 0 ? 64 : 32;
  __syncthreads();
  if (tid == 0) {
    int a = 0;
    for (int i = 0; i < nl; ++i) { pre[i] = a; const int li = mode == 0 ? i : i * 2 + (mode - 1); a += (cnt[li] + 255) >> 8; }
    pre[nl] = a;
    int b = 0;
    for (int i = 0; i < 64; ++i) { lb[i] = b; b += cnt[i]; }
  }
  __syncthreads();
  XSched xs; xs.init(pre[nl], 4);
  int tile, nt2;
  while (xs.next(tile, nt2)) {
    int sl = 0;
    while (pre[sl + 1] <= tile) ++sl;
    const int li = mode == 0 ? sl : sl * 2 + (mode - 1);
    const int e = li >> 1, k = li & 1;
    const int r0 = (tile - pre[sl]) * 256, n = cnt[li];
    if (tid < 256) { int idx = r0 + tid; if (idx >= n) idx = n - 1; rowtok[tid] = list[(size_t)li * T + idx]; }
    if (mode == 2) {
      for (int i = tid; i < NBR * 64; i += NT) {
        const int brr = i >> 6, cc = (i & 63) * 4;
        *(float4*)(g2t + brr * 256 + cc) = *(const float4*)(mod + brr * 6144 + 5 * 1024 + nt2 * 256 + cc);
      }
    }
    __syncthreads();
    if (mode == 0) {
      const bfr* Wt = (const bfr*)(ws + WS_WGU) + (size_t)e * 1024 * 1024;
      auto arow = [&](int row) { return H + (size_t)rowtok[row] * D; };
      auto brow = [&](int row256) { const int nt = nt2 * 2 + (row256 >> 7), row = row256 & 127; const int c = row < 64 ? nt * 64 + row : 512 + nt * 64 + (row - 64); return Wt + (size_t)c * 32; };
      auto epi = [&](int half, int ch, int tid) {
        const int nt = nt2 * 2 + ch;
        const bfr* Cs = Cs0 + half * 128 * CSS + ch * 128;
        const int row = tid & 127, hf = tid >> 7, grow = half * 128 + row;
        if (r0 + grow < n) {
          bfr* dst = act + ((size_t)(nt * 2 + hf) * (2 * T) + (lb[li] + r0 + grow)) * 32;
#pragma unroll
          for (int q = 0; q < 4; ++q) {
            float z[8];
#pragma unroll
            for (int u = 0; u < 2; ++u) {
              float4 g = cs4(Cs, row, hf * 32 + q * 8 + u * 4);
              float4 up = cs4(Cs, row, 64 + hf * 32 + q * 8 + u * 4);
              z[u * 4 + 0] = g.x / (1.f + __expf(-g.x)) * up.x; z[u * 4 + 1] = g.y / (1.f + __expf(-g.y)) * up.y;
              z[u * 4 + 2] = g.z / (1.f + __expf(-g.z)) * up.z; z[u * 4 + 3] = g.w / (1.f + __expf(-g.w)) * up.w;
            }
            u32x4 o; o[0] = pk2(z[0], z[1]); o[1] = pk2(z[2], z[3]); o[2] = pk2(z[4], z[5]); o[3] = pk2(z[6], z[7]);
            *(u32x4*)(dst + q * 8) = o;
          }
        }
      };
      gemm_tile(lds, 1024, 32, 1024 * 32, arow, brow, epi);
    } else {
      const bfr* Wt = (const bfr*)(ws + WS_WD) + (size_t)e * 1024 * 512;
      auto arow = [&](int row) { int sl_ = lb[li] + r0 + row; if (sl_ > 2 * T - 1) sl_ = 2 * T - 1; return act + (size_t)sl_ * 32; };
      auto brow = [&](int row) { return Wt + (size_t)(nt2 * 256 + row) * 32; };
      bfr* Y0 = (bfr*)(ws + WS_H);
      auto epi = [&](int half, int ch, int tid) {
        const bfr* Cs = Cs0 + half * 128 * CSS + ch * 128;
        const int c4 = (tid & 31) * 4, col = nt2 * 256 + ch * 128 + c4;
        if (mode == 1) {
          float gt[16]; int tk[16];
#pragma unroll
          for (int ps = 0; ps < 16; ++ps) {
            const int grow = half * 128 + ps * 8 + (tid >> 5);
            tk[ps] = rowtok[grow];
            gt[ps] = gate[(size_t)k * T + tk[ps]];
          }
          asm volatile("" ::: "memory");
#pragma unroll
          for (int ps = 0; ps < 16; ++ps) {
            const int row = ps * 8 + (tid >> 5);
            if (r0 + half * 128 + row < n) {
              float4 c = cs4(Cs, row, c4);
              const float g = gt[ps];
              u32x2 o; o[0] = pk2(g * c.x, g * c.y); o[1] = pk2(g * c.z, g * c.w);
              *(u32x2*)(Y0 + (size_t)tk[ps] * D + col) = o;
            }
          }
        } else {
          float4 ov[16]; u32x2 yv[16]; float gt[16]; int tk[16];
#pragma unroll
          for (int ps = 0; ps < 16; ++ps) {
            const int grow = half * 128 + ps * 8 + (tid >> 5);
            tk[ps] = rowtok[grow];
            gt[ps] = gate[(size_t)k * T + tk[ps]];
            ov[ps] = *(const float4*)(p.out + (size_t)tk[ps] * D + col);
            yv[ps] = *(const u32x2*)(Y0 + (size_t)tk[ps] * D + col);
          }
          asm volatile("" ::: "memory");
#pragma unroll
          for (int ps = 0; ps < 16; ++ps) {
            const int row = ps * 8 + (tid >> 5);
            if (r0 + half * 128 + row < n) {
              int br, s_, S_; tok_info(tk[ps], br, s_, S_);
              const float4 g2 = *(const float4*)(g2t + br * 256 + ch * 128 + c4);
              float4 c = cs4(Cs, row, c4);
              float4 o = ov[ps];
              const float g = gt[ps];
              o.x += g2.x * (__uint_as_float(yv[ps][0] << 16) + g * c.x);
              o.y += g2.y * (__uint_as_float(yv[ps][0] & 0xffff0000u) + g * c.y);
              o.z += g2.z * (__uint_as_float(yv[ps][1] << 16) + g * c.z);
              o.w += g2.w * (__uint_as_float(yv[ps][1] & 0xffff0000u) + g * c.w);
              *(float4*)(p.out + (size_t)tk[ps] * D + col) = o;
            }
          }
        }
      };
      gemm_tile(lds, 512, 2 * T * 32, 1024 * 32, arow, brow, epi);
    }
    __syncthreads();
  }
}

__global__ void __launch_bounds__(NT, 2) fwd_kernel(Params p) {
  __shared__ __attribute__((aligned(1024))) char lds[LDS_BYTES];
  cg::grid_group grid = cg::this_grid();
  const int lo = p.ph_lo, hi = p.ph_hi;
#define RUN(k, call) if (lo <= (k) && (k) < hi) { if ((k) > lo) grid.sync(); if (PHMASK & (1 << (k))) { call; } }
  RUN(0, phase0(p, lds))
  RUN(1, phase1(p))
  RUN(2, phase2(p, lds))
  RUN(3, phase3(p, lds))
  RUN(4, phase4(p, lds))
  RUN(5, phase5(p, lds))
  RUN(6, phase_moe(p, lds, 0))
  RUN(7, phase_moe(p, lds, 1))
  RUN(8, phase_moe(p, lds, 2))
#undef RUN
}

extern "C" void kernel_launch(void* const* d_in, const int* in_sizes, int n_in, void* d_out, int out_size, void* d_ws, size_t ws_size,
                              hipStream_t stream) {
  static int grid_blocks = 0;
  if (!grid_blocks) {
    int dev = 0, cus = 0, per_cu = 0;
    hipGetDevice(&dev);
    hipDeviceGetAttribute(&cus, hipDeviceAttributeMultiprocessorCount, dev);
    hipOccupancyMaxActiveBlocksPerMultiprocessor(&per_cu, fwd_kernel, NT, 0);
    if (per_cu < 1) per_cu = 1;
    if (per_cu > 1) per_cu = 1;
    grid_blocks = cus * per_cu;
  }
  Params p;
  memset(&p, 0, sizeof(p));
  const float** f = (const float**)&p.xp;
  for (int i = 0; i < 27; ++i) f[i] = (const float*)d_in[i];
  p.out = (float*)d_out;
  p.ws = (unsigned char*)d_ws;
  for (int i = 0; i < 8; ++i) p.inv_freq[i] = pow(500000.0, -(2.0 * i) / 16.0);
#if N_LAUNCH_MODE == 1
  for (int ph = 0; ph < NPHASE; ++ph) {
    p.ph_lo = ph; p.ph_hi = ph + 1;
    hipLaunchKernelGGL(fwd_kernel, dim3(grid_blocks), dim3(NT), 0, stream, p);
    if (PROBE_MASK & (1 << ph)) { p.dummy = 1; hipLaunchKernelGGL(fwd_kernel, dim3(grid_blocks), dim3(NT), 0, stream, p); p.dummy = 0; }
  }
#else
  p.ph_lo = 0; p.ph_hi = NPHASE;
  void* args[] = {&p};
  hipLaunchCooperativeKernel((const void*)fwd_kernel, dim3(grid_blocks), dim3(NT), args, 0, stream);
#endif
}
```

```cpp
#include <hip/hip_runtime.h>
#include <hip/hip_cooperative_groups.h>
#include <math.h>
#include <string.h>
namespace cg = cooperative_groups;

#ifndef PHMASK
#define PHMASK 0x1ff
#endif
#ifndef PROBE_MASK
#define PROBE_MASK 0
#endif
#ifndef N_LAUNCH_MODE
#define N_LAUNCH_MODE 0
#endif

typedef unsigned short bfr;
using bf16x8 = __attribute__((ext_vector_type(8))) short;
using f32x16 = __attribute__((ext_vector_type(16))) float;
using u32x4 = __attribute__((ext_vector_type(4))) unsigned;
using u32x2 = __attribute__((ext_vector_type(2))) unsigned;
typedef __bf16 bf2_t __attribute__((ext_vector_type(2)));
typedef float fl2_t __attribute__((ext_vector_type(2)));

#define DI __device__ __forceinline__
#define MFMA(a, b, c) __builtin_amdgcn_mfma_f32_32x32x16_bf16((a), (b), (c), 0, 0, 0)

constexpr int D = 1024;
constexpr int TP = 65536, TS = 32768, T = TP + TS;
constexpr int NBR = 18;
constexpr int LDS_BYTES = 155648;
constexpr int NT = 512;
constexpr int VLDS = 65536;
constexpr int NPHASE = 9;

constexpr size_t WS_MOD = 0;
constexpr size_t WS_ROPE = 458752;
constexpr size_t WS_WRT = WS_ROPE + 1048576;
constexpr size_t WS_CNT = WS_WRT + 147456;
constexpr size_t WS_WIN = WS_CNT + 1024;
constexpr size_t WS_WOUT = WS_WIN + 5242880;
constexpr size_t WS_WGU = WS_WOUT + 2097152;
constexpr size_t WS_WD = WS_WGU + 67108864;
constexpr size_t WS_H = WS_WD + 33554432;
constexpr size_t WS_Q = WS_H + (size_t)T * 1024 * 2;
constexpr size_t WS_K = WS_Q + (size_t)T * 512 * 2;
constexpr size_t WS_VT = WS_K + (size_t)T * 512 * 2;
constexpr size_t WS_Z = WS_VT + (size_t)T * 512 * 2;
constexpr size_t WS_ACT = WS_Q;
constexpr size_t WS_LIST = WS_VT;
constexpr size_t WS_GATE = WS_Z;

struct Params {
  const float *xp, *xs, *cp, *cs, *w_ada, *b_ada, *g_norm1, *w_in, *g_q, *g_k, *lq1, *lk1, *lq2, *lk2, *g_subln, *w_dw, *b_dw,
      *g_cln, *b_cln, *w_out, *g_norm2, *w_rg, *b_rg, *w_re, *b_re, *w_gu, *w_d;
  float* out;
  unsigned char* ws;
  double inv_freq[8];
  int ph_lo, ph_hi, dummy, pad_;
};

DI unsigned pk2(float a, float b) { fl2_t f = {a, b}; bf2_t r = __builtin_convertvector(f, bf2_t); return __builtin_bit_cast(unsigned, r); }
DI float wave_sum(float v) {
#pragma unroll
  for (int o = 32; o > 0; o >>= 1) v += __shfl_xor(v, o, 64);
  return v;
}
DI void dma16(const void* src, void* lds_wave_base) { __builtin_amdgcn_global_load_lds((const unsigned*)src, (unsigned*)lds_wave_base, 16, 0, 0); }
DI void wait_vm0() { asm volatile("s_waitcnt vmcnt(0)" ::: "memory"); }
DI bf16x8 frag(const char* img, int row, int chunk) { return *(const bf16x8*)(img + row * 128 + ((chunk ^ ((row >> 1) & 7)) << 4)); }
DI void tok_info(int t, int& br, int& s, int& S) {
  if (t < TP) { br = t >> 12; s = t & 4095; S = 4096; } else { int u = t - TP; br = 16 + (u >> 14); s = u & 16383; S = 16384; }
}
DI const float* xrow(const Params& p, int t) { return t < TP ? p.xp + (size_t)t * D : p.xs + (size_t)(t - TP) * D; }

DI void transpose_tile(const float* __restrict__ src, bfr* __restrict__ dst, int K, int N, int k0, int n0, float* lds, int tid) {
#pragma unroll
  for (int ps = 0; ps < 4; ++ps) {
    int kk = ps * 16 + (tid >> 4), n4 = (tid & 15) * 4;
    float4 v = *(const float4*)(src + (size_t)(k0 + kk) * N + n0 + n4);
    lds[kk * 65 + n4 + 0] = v.x; lds[kk * 65 + n4 + 1] = v.y; lds[kk * 65 + n4 + 2] = v.z; lds[kk * 65 + n4 + 3] = v.w;
  }
  __syncthreads();
#pragma unroll
  for (int ps = 0; ps < 2; ++ps) {
    int nn = ps * 32 + (tid >> 3), kc = (tid & 7) * 8;
    u32x4 o;
    o[0] = pk2(lds[(kc + 0) * 65 + nn], lds[(kc + 1) * 65 + nn]);
    o[1] = pk2(lds[(kc + 2) * 65 + nn], lds[(kc + 3) * 65 + nn]);
    o[2] = pk2(lds[(kc + 4) * 65 + nn], lds[(kc + 5) * 65 + nn]);
    o[3] = pk2(lds[(kc + 6) * 65 + nn], lds[(kc + 7) * 65 + nn]);
    *(u32x4*)(dst + ((size_t)((k0 + kc) >> 5) * N + (n0 + nn)) * 32 + ((k0 + kc) & 31)) = o;
  }
  __syncthreads();
}

DI void phase0(const Params& p, char* lds0) {
  const int vb = threadIdx.x >> 8, tid = threadIdx.x & 255, G = gridDim.x, bid = blockIdx.x;
  char* lds = lds0 + vb * VLDS;
  const int gtid = bid * NT + threadIdx.x, gsz = G * NT;
  unsigned char* ws = p.ws;
  if (bid == 0 && threadIdx.x < 128) ((int*)(ws + WS_CNT))[threadIdx.x] = 0;
  float2* rope = (float2*)(ws + WS_ROPE);
  for (int i = gtid; i < 16384 * 8; i += gsz) {
    int s = i >> 3, f = i & 7;
    double a = (double)s * p.inv_freq[f];
    double n = rint(a * 0.15915494309189535);
    float r = (float)(a - n * 6.283185307179586);
    rope[i] = make_float2(__cosf(r), __sinf(r));
  }
  float* wrt = (float*)(ws + WS_WRT);
  for (int i = gtid; i < 36 * 1024; i += gsz) {
    int n = i >> 10, k = i & 1023;
    wrt[i] = n < 4 ? p.w_rg[k * 4 + n] : p.w_re[k * 32 + (n - 4)];
  }
  float* mod = (float*)(ws + WS_MOD);
  {
    float* sc = (float*)lds;
    float* red = (float*)(lds + 40960);
    const int w = tid >> 6, lane = tid & 63;
    for (int item0 = bid; item0 < 48; item0 += G) {
      const int item = item0 * 2 + vb;
      const int col = item * 64 + lane;
      float acc[NBR];
#pragma unroll
      for (int r = 0; r < NBR; ++r) acc[r] = 0.f;
      for (int kh = 0; kh < 2; ++kh) {
        __syncthreads();
        for (int idx = tid; idx < NBR * 512; idx += 256) {
          int r = idx >> 9, k = idx & 511;
          float c = r < 16 ? p.cp[r * 1024 + kh * 512 + k] : p.cs[(r - 16) * 1024 + kh * 512 + k];
          sc[k * 20 + r] = c / (1.f + __expf(-c));
        }
        __syncthreads();
        for (int i = 0; i < 128; ++i) {
          const int kl = w * 128 + i;
          const float wv = p.w_ada[(size_t)(kh * 512 + kl) * 6144 + col];
          const float4* s4 = (const float4*)(sc + kl * 20);
          float4 a0 = s4[0], a1 = s4[1], a2 = s4[2], a3 = s4[3];
          float2 a4 = *(const float2*)(sc + kl * 20 + 16);
          acc[0] += a0.x * wv; acc[1] += a0.y * wv; acc[2] += a0.z * wv; acc[3] += a0.w * wv;
          acc[4] += a1.x * wv; acc[5] += a1.y * wv; acc[6] += a1.z * wv; acc[7] += a1.w * wv;
          acc[8] += a2.x * wv; acc[9] += a2.y * wv; acc[10] += a2.z * wv; acc[11] += a2.w * wv;
          acc[12] += a3.x * wv; acc[13] += a3.y * wv; acc[14] += a3.z * wv; acc[15] += a3.w * wv;
          acc[16] += a4.x * wv; acc[17] += a4.y * wv;
        }
      }
      __syncthreads();
#pragma unroll
      for (int r = 0; r < NBR; ++r) red[(w * NBR + r) * 64 + lane] = acc[r];
      __syncthreads();
      for (int idx = tid; idx < NBR * 64; idx += 256) {
        int r = idx >> 6, l = idx & 63;
        float s = red[(0 * NBR + r) * 64 + l] + red[(1 * NBR + r) * 64 + l] + red[(2 * NBR + r) * 64 + l] + red[(3 * NBR + r) * 64 + l];
        mod[r * 6144 + item * 64 + l] = s + p.b_ada[item * 64 + l];
      }
      __syncthreads();
    }
  }
  {
    float* tl = (float*)lds;
    const int n_in = 16 * 40, n_out = 16 * 16, n_gu = 32 * 256, n_d = 32 * 128;
    const int total = n_in + n_out + n_gu + n_d;
    for (int it0 = bid; it0 < total / 2; it0 += G) {
      const int it = it0 * 2 + vb;
      if (it < n_in) {
        int kt = it / 40, nt = it % 40;
        transpose_tile(p.w_in, (bfr*)(ws + WS_WIN), 1024, 2560, kt * 64, nt * 64, tl, tid);
      } else if (it < n_in + n_out) {
        int i2 = it - n_in; int kt = i2 >> 4, nt = i2 & 15;
        transpose_tile(p.w_out, (bfr*)(ws + WS_WOUT), 1024, 1024, kt * 64, nt * 64, tl, tid);
      } else if (it < n_in + n_out + n_gu) {
        int i2 = it - n_in - n_out; int e = i2 >> 8, r = i2 & 255; int kt = r >> 4, nt = r & 15;
        transpose_tile(p.w_gu + (size_t)e * 1024 * 1024, (bfr*)(ws + WS_WGU) + (size_t)e * 1024 * 1024, 1024, 1024, kt * 64, nt * 64, tl, tid);
      } else {
        int i2 = it - n_in - n_out - n_gu; int e = i2 >> 7, r = i2 & 127; int kt = r >> 4, nt = r & 15;
        transpose_tile(p.w_d + (size_t)e * 512 * 1024, (bfr*)(ws + WS_WD) + (size_t)e * 1024 * 512, 512, 1024, kt * 64, nt * 64, tl, tid);
      }
    }
  }
}

DI void phase1(const Params& p) {
  const int tid = threadIdx.x, w = tid >> 6, lane = tid & 63;
  const float* mod = (const float*)(p.ws + WS_MOD);
  bfr* H = (bfr*)(p.ws + WS_H);
  const int nwv = gridDim.x * 8, per = (T + nwv - 1) / nwv;
  const int t_begin = (blockIdx.x * 8 + w) * per, t_end = t_begin + per < T ? t_begin + per : T;
  if (t_begin >= t_end) return;
  float4 nx[4], csv[4], shv[4];
#pragma unroll
  for (int j = 0; j < 4; ++j) nx[j] = *(const float4*)(xrow(p, t_begin) + j * 256 + lane * 4);
  int cur_br = -1;
  for (int t = t_begin; t < t_end; ++t) {
    int br, s, S; tok_info(t, br, s, S);
    if (br != cur_br) {
      cur_br = br;
      const float* sh = mod + br * 6144, *scl = mod + br * 6144 + 1024;
#pragma unroll
      for (int j = 0; j < 4; ++j) {
        const int c = j * 256 + lane * 4;
        float4 g = *(const float4*)(p.g_norm1 + c), a = *(const float4*)(scl + c);
        csv[j] = make_float4(g.x * (1.f + a.x), g.y * (1.f + a.y), g.z * (1.f + a.z), g.w * (1.f + a.w));
        shv[j] = *(const float4*)(sh + c);
      }
    }
    float4 v[4];
#pragma unroll
    for (int j = 0; j < 4; ++j) v[j] = nx[j];
    if (t + 1 < t_end) {
      const float* x1 = xrow(p, t + 1);
#pragma unroll
      for (int j = 0; j < 4; ++j) nx[j] = *(const float4*)(x1 + j * 256 + lane * 4);
    }
    float ss = 0.f;
#pragma unroll
    for (int j = 0; j < 4; ++j) ss += v[j].x * v[j].x + v[j].y * v[j].y + v[j].z * v[j].z + v[j].w * v[j].w;
    ss = wave_sum(ss);
    const float rstd = rsqrtf(ss * (1.f / 1024.f) + 1e-6f);
#pragma unroll
    for (int j = 0; j < 4; ++j) {
      const int c = j * 256 + lane * 4;
      float o0 = v[j].x * rstd * csv[j].x + shv[j].x, o1 = v[j].y * rstd * csv[j].y + shv[j].y;
      float o2 = v[j].z * rstd * csv[j].z + shv[j].z, o3 = v[j].w * rstd * csv[j].w + shv[j].w;
      u32x2 o; o[0] = pk2(o0, o1); o[1] = pk2(o2, o3);
      *(u32x2*)(H + (size_t)t * D + c) = o;
    }
  }
}

constexpr int CSS = 264;
DI float bf2f(bfr v) { return __uint_as_float((unsigned)v << 16); }
DI float4 cs4(const bfr* Cs, int row, int col) {
  const u32x2 u = *(const u32x2*)(Cs + row * CSS + col);
  return make_float4(__uint_as_float(u[0] << 16), __uint_as_float(u[0] & 0xffff0000u), __uint_as_float(u[1] << 16), __uint_as_float(u[1] & 0xffff0000u));
}
#define WAIT_V(n) asm volatile("s_waitcnt vmcnt(%0)" ::"n"(n) : "memory")
#define RAW_BARRIER() do { asm volatile("s_waitcnt lgkmcnt(0)" ::: "memory"); __builtin_amdgcn_s_barrier(); } while (0)
template <typename FA, typename FB, typename FE>
DI void gemm_tile(char* lds, int K, int astride, int bstride, FA arow, FB brow, FE epi) {
  const int tid = threadIdx.x, w = __builtin_amdgcn_readfirstlane(tid >> 6), lane = tid & 63, r = lane & 31, h8 = lane >> 5;
  const int wm = w >> 1, wn = w & 1;
  const bfr* ap[2]; const bfr* bp[2];
#pragma unroll
  for (int i = 0; i < 2; ++i) {
    const int row = (w * 2 + i) * 16 + (lane >> 2);
    const int sw = ((lane & 3) ^ ((row >> 2) & 3)) * 8;
    ap[i] = arow(row) + sw;
    bp[i] = brow(row) + sw;
  }
  int foff[2];
#pragma unroll
  for (int ks = 0; ks < 2; ++ks) foff[ks] = r * 64 + (((ks * 2 + h8) ^ ((r >> 2) & 3)) << 4);
  f32x16 acc[2][4];
#pragma unroll
  for (int a = 0; a < 2; ++a)
#pragma unroll
    for (int b = 0; b < 4; ++b)
#pragma unroll
      for (int i = 0; i < 16; ++i) acc[a][b][i] = 0.f;
  const int nk = K >> 5;
  auto stage = [&](int buf, int kt) {
    char* sa = lds + buf * 32768;
#pragma unroll
    for (int i = 0; i < 2; ++i) {
      dma16(ap[i] + (size_t)kt * astride, sa + (w * 2 + i) * 1024);
      dma16(bp[i] + (size_t)kt * bstride, sa + 16384 + (w * 2 + i) * 1024);
    }
  };
  stage(0, 0); stage(1, 1); stage(2, 2);
  for (int kt = 0; kt < nk; ++kt) {
    if (kt + 2 < nk) WAIT_V(8); else if (kt + 1 < nk) WAIT_V(4); else WAIT_V(0);
    RAW_BARRIER();
    if (kt + 3 < nk) stage((kt + 3) & 3, kt + 3);
    const char* sa = lds + (kt & 3) * 32768 + wm * 4096;
    const char* sb = lds + (kt & 3) * 32768 + 16384 + wn * 8192;
#pragma unroll
    for (int ks = 0; ks < 2; ++ks) {
      bf16x8 a0 = *(const bf16x8*)(sa + foff[ks]), a1 = *(const bf16x8*)(sa + 2048 + foff[ks]);
#pragma unroll
      for (int nt = 0; nt < 4; ++nt) {
        bf16x8 bb = *(const bf16x8*)(sb + nt * 2048 + foff[ks]);
        acc[0][nt] = MFMA(a0, bb, acc[0][nt]);
        acc[1][nt] = MFMA(a1, bb, acc[1][nt]);
      }
    }
  }
  RAW_BARRIER();
  bfr* Cs = (bfr*)lds;
#pragma unroll
  for (int mt = 0; mt < 2; ++mt)
#pragma unroll
    for (int nt = 0; nt < 4; ++nt)
#pragma unroll
      for (int i = 0; i < 16; i += 2) {
        const int row = wm * 64 + mt * 32 + (i & 3) + 8 * (i >> 2) + 4 * h8;
        const unsigned pr = pk2(acc[mt][nt][i], acc[mt][nt][i + 1]);
        Cs[row * CSS + wn * 128 + nt * 32 + r] = (bfr)(pr & 0xffffu);
        Cs[(row + 1) * CSS + wn * 128 + nt * 32 + r] = (bfr)(pr >> 16);
      }
  __syncthreads();
  {
    const int vb = tid >> 8, vtid = tid & 255;
    epi(vb, 0, vtid);
    epi(vb, 1, vtid);
  }
  __syncthreads();
}

struct XSched {
  int xcd, slot, nslot, nmaj_x, nminor, j, total;
  DI void init(int nmajor, int nminor_) {
    const int G = gridDim.x, b = blockIdx.x;
    if (G % 8 == 0) { xcd = b & 7; slot = b >> 3; nslot = G >> 3; nmaj_x = (nmajor - xcd + 7) >> 3; }
    else { xcd = 0; slot = b; nslot = G; nmaj_x = nmajor; }
    nminor = nminor_; j = slot; total = nmaj_x * nminor;
  }
  DI bool next(int& major, int& minor) {
    if (j >= total) return false;
    const int mj = j / nminor; minor = j - mj * nminor;
    major = (gridDim.x % 8 == 0) ? xcd + 8 * mj : mj;
    j += nslot;
    return true;
  }
};

DI void phase2(const Params& p, char* lds) {
  unsigned char* ws = p.ws;
  const bfr* H = (const bfr*)(ws + WS_H);
  const bfr* Wt = (const bfr*)(ws + WS_WIN);
  const bfr* Cs0 = (const bfr*)lds;
  const float2* rope = (const float2*)(ws + WS_ROPE);
  const float qscale = 0.125f * 1.4426950408889634f;
  XSched xs; xs.init(384, 10);
  int mt, nt2;
  while (xs.next(mt, nt2)) {
    const int t0 = mt * 256;
    int br, s0f, S; tok_info(t0, br, s0f, S);
    const int bl = t0 < TP ? br : br - 16;
    const size_t gbase = t0 < TP ? 0 : (size_t)TP * 512;
    auto arow = [&](int row) { return H + (size_t)(t0 + row) * D; };
    auto brow = [&](int row256) {
      const int nt = nt2 * 2 + (row256 >> 7), row = row256 & 127;
      int n;
      if (nt < 12) n = nt * 128 + row; else { int j = nt - 12; n = row < 64 ? 1536 + j * 64 + row : 2048 + j * 64 + (row - 64); }
      return Wt + (size_t)n * 32;
    };
    auto epi = [&](int half, int ch, int tid) {
    const int nt = nt2 * 2 + ch;
    const bfr* Cs = Cs0 + half * 128 * CSS + ch * 128;
    const int s0 = s0f + half * 128, t0h = t0 + half * 128;
    if (nt < 8) {
      const bool isK = nt >= 4;
      const int row = tid & 127, hmi = tid >> 7, hm = (nt & 3) * 2 + hmi;
      const float* gsrc = isK ? p.g_k : p.g_q;
      float v[64];
      float ss = 0.f;
#pragma unroll
      for (int j = 0; j < 16; ++j) {
        float4 c4 = cs4(Cs, row, hmi * 64 + j * 4);
        v[j * 4 + 0] = c4.x; v[j * 4 + 1] = c4.y; v[j * 4 + 2] = c4.z; v[j * 4 + 3] = c4.w;
        ss += c4.x * c4.x + c4.y * c4.y + c4.z * c4.z + c4.w * c4.w;
      }
      const float rstd = rsqrtf(ss * (1.f / 64.f) + 1e-6f);
#pragma unroll
      for (int j = 0; j < 16; ++j) {
        float4 g = *(const float4*)(gsrc + j * 4);
        v[j * 4 + 0] *= rstd * g.x; v[j * 4 + 1] *= rstd * g.y; v[j * 4 + 2] *= rstd * g.z; v[j * 4 + 3] *= rstd * g.w;
      }
      const int s = s0 + row;
#pragma unroll
      for (int i = 0; i < 8; ++i) {
        float2 cs = rope[s * 8 + i];
        float x1 = v[i], x2 = v[i + 8];
        v[i] = x1 * cs.x - x2 * cs.y;
        v[i + 8] = x2 * cs.x + x1 * cs.y;
      }
      const float sc = isK ? 1.f : qscale;
      bfr* dst = (bfr*)(ws + (isK ? WS_K : WS_Q)) + gbase + ((size_t)(bl * 8 + hm) * S + s) * 64;
#pragma unroll
      for (int j = 0; j < 8; ++j) {
        u32x4 o;
        o[0] = pk2(v[j * 8 + 0] * sc, v[j * 8 + 1] * sc); o[1] = pk2(v[j * 8 + 2] * sc, v[j * 8 + 3] * sc);
        o[2] = pk2(v[j * 8 + 4] * sc, v[j * 8 + 5] * sc); o[3] = pk2(v[j * 8 + 6] * sc, v[j * 8 + 7] * sc);
        *(u32x4*)(dst + j * 8) = o;
      }
    } else if (nt < 12) {
      const int h = nt - 8, e = tid & 127, tg = tid >> 7;
      bfr* vb = (bfr*)(ws + WS_VT) + gbase + (size_t)(bl * 4 + h) * 128 * S;
#pragma unroll
      for (int g = 0; g < 4; ++g) {
        float v[16];
#pragma unroll
        for (int q = 0; q < 16; ++q) {
          const int key = 8 * ((q >> 2) & 1) + 4 * (q >> 3) + (q & 3);
          v[q] = bf2f(Cs[(tg * 64 + g * 16 + key) * CSS + e]);
        }
        u32x4 o0, o1;
        o0[0] = pk2(v[0], v[1]); o0[1] = pk2(v[2], v[3]); o0[2] = pk2(v[4], v[5]); o0[3] = pk2(v[6], v[7]);
        o1[0] = pk2(v[8], v[9]); o1[1] = pk2(v[10], v[11]); o1[2] = pk2(v[12], v[13]); o1[3] = pk2(v[14], v[15]);
        const int sk = s0 + tg * 64 + g * 16;
        bfr* dst = vb + ((size_t)(sk >> 5) * 128 + e) * 32 + (sk & 16);
        *(u32x4*)(dst) = o0;
        *(u32x4*)(dst + 8) = o1;
      }
    } else {
      const int j = nt - 12, row = tid & 127, hf = tid >> 7;
      bfr* dst = (bfr*)(ws + WS_Z) + (size_t)(t0h + row) * 512 + j * 64 + hf * 32;
#pragma unroll
      for (int q = 0; q < 4; ++q) {
        float z[8];
#pragma unroll
        for (int u = 0; u < 2; ++u) {
          float4 a = cs4(Cs, row, hf * 32 + q * 8 + u * 4);
          float4 g = cs4(Cs, row, 64 + hf * 32 + q * 8 + u * 4);
          z[u * 4 + 0] = a.x / (1.f + __expf(-g.x)); z[u * 4 + 1] = a.y / (1.f + __expf(-g.y));
          z[u * 4 + 2] = a.z / (1.f + __expf(-g.z)); z[u * 4 + 3] = a.w / (1.f + __expf(-g.w));
        }
        u32x4 o; o[0] = pk2(z[0], z[1]); o[1] = pk2(z[2], z[3]); o[2] = pk2(z[4], z[5]); o[3] = pk2(z[6], z[7]);
        *(u32x4*)(dst + q * 8) = o;
      }
    }
    };
    gemm_tile(lds, 1024, 32, 2560 * 32, arow, brow, epi);
  }
}

DI void attn_item(const Params& p, char* lds, int S, const bfr* Qb, const bfr* Kb, const bfr* Vtb, int h, int q0, int tok0) {
  const int tid = threadIdx.x, w = __builtin_amdgcn_readfirstlane(tid >> 6), lane = tid & 63, r = lane & 31, h8 = lane >> 5;
  const int c = w & 1, qg = w >> 1;
  f32x16 O[2][4];
#pragma unroll
  for (int t = 0; t < 2; ++t)
#pragma unroll
    for (int e = 0; e < 4; ++e)
#pragma unroll
      for (int i = 0; i < 16; ++i) O[t][e][i] = 0.f;
  float m[2] = {-64.f, -64.f}, l[2] = {0.f, 0.f};
  const int nkt = S >> 5;
  int voffK[4];
#pragma unroll
  for (int ks = 0; ks < 4; ++ks) voffK[ks] = r * 128 + (((ks * 2 + h8) ^ ((r >> 1) & 7)) << 4);
  const int voffV0 = r * 64 + ((h8 ^ ((r >> 2) & 3)) << 4);
  const int lr = lane >> 3, sl = lane & 7;
  const char* k0p = (const char*)(Kb + (size_t)(h * 2) * S * 64);
  const char* k1p = (const char*)(Kb + (size_t)(h * 2 + 1) * S * 64);
  const char* vtp = (const char*)Vtb;
  unsigned ko, vo;
  { const int row = (w & 3) * 8 + lr; ko = (unsigned)(row * 128 + ((sl ^ ((row >> 1) & 7)) << 4)); }
  { const int row = w * 16 + (lane >> 2); vo = (unsigned)(row * 64 + (((lane & 3) ^ ((row >> 2) & 3)) << 4)); }
  const char* kxp = w < 4 ? k0p : k1p;
  auto stage = [&](int buf, int kt) {
    char* sb = lds + 65536 + buf * 16384;
    dma16(kxp + (size_t)kt * 4096 + ko, sb + w * 1024);
    dma16(vtp + (size_t)kt * 8192 + vo, sb + 8192 + w * 1024);
  };
  __syncthreads();
  {
    const char* qp = (const char*)(Qb + ((size_t)(h * 2 + c) * S + q0 + qg * 64) * 64);
    int lq = threadIdx.x & 63;
    asm volatile("" : "+v"(lq));
    const int lrq = lq >> 3, slq = lq & 7;
#pragma unroll
    for (int i = 0; i < 8; ++i) {
      const int row = i * 8 + lrq;
      dma16(qp + row * 128 + ((slq ^ ((row >> 1) & 7)) << 4), lds + w * 8192 + i * 1024);
    }
  }
  stage(0, 0); stage(1, 1); stage(2, 2);
  const char* qimg = lds + w * 8192;
#pragma unroll 8
  for (int kt = 0; kt < nkt; ++kt) {
    if (kt + 2 < nkt) WAIT_V(4); else if (kt + 1 < nkt) WAIT_V(2); else WAIT_V(0);
    RAW_BARRIER();
    if (kt + 3 < nkt) stage((kt + 3) & 3, kt + 3);
    const char* sb = lds + 65536 + (kt & 3) * 16384;
    const char* kimg = sb + c * 4096;
    const char* vimg = sb + 8192;
    f32x16 st[2];
    {
      bf16x8 kf[4];
#pragma unroll
      for (int ks = 0; ks < 4; ++ks) kf[ks] = *(const bf16x8*)(kimg + voffK[ks]);
#pragma unroll
      for (int t = 0; t < 2; ++t) {
        const float negm = -m[t];
#pragma unroll
        for (int i = 0; i < 16; ++i) st[t][i] = negm;
#pragma unroll
        for (int ks = 0; ks < 4; ++ks) st[t] = MFMA(kf[ks], *(const bf16x8*)(qimg + t * 4096 + voffK[ks]), st[t]);
      }
    }
#pragma unroll
    for (int t = 0; t < 2; ++t) {
      float mx = st[t][0];
#pragma unroll
      for (int i = 1; i < 16; ++i) mx = fmaxf(mx, st[t][i]);
      mx = fmaxf(mx, __shfl_xor(mx, 32, 64));
      if (__any(mx > 6.f)) {
        const float d = fmaxf(mx, 0.f);
        const float alpha = __builtin_amdgcn_exp2f(-d);
        m[t] += d;
        l[t] *= alpha;
#pragma unroll
        for (int i = 0; i < 16; ++i) st[t][i] -= d;
#pragma unroll
        for (int e = 0; e < 4; ++e)
#pragma unroll
          for (int i = 0; i < 16; ++i) O[t][e][i] *= alpha;
      }
    }
    __builtin_amdgcn_iglp_opt(0);
#pragma unroll
    for (int t = 0; t < 2; ++t) {
      float rs = 0.f;
#pragma unroll
      for (int i = 0; i < 16; ++i) { float pv = __builtin_amdgcn_exp2f(st[t][i]); st[t][i] = pv; rs += pv; }
      l[t] += rs;
      bf16x8 pf[2];
#pragma unroll
      for (int kc = 0; kc < 2; ++kc) {
        u32x4 pp;
        pp[0] = pk2(st[t][kc * 8 + 0], st[t][kc * 8 + 1]); pp[1] = pk2(st[t][kc * 8 + 2], st[t][kc * 8 + 3]);
        pp[2] = pk2(st[t][kc * 8 + 4], st[t][kc * 8 + 5]); pp[3] = pk2(st[t][kc * 8 + 6], st[t][kc * 8 + 7]);
        pf[kc] = __builtin_bit_cast(bf16x8, pp);
      }
#pragma unroll
      for (int e = 0; e < 4; ++e)
#pragma unroll
        for (int kc = 0; kc < 2; ++kc) O[t][e] = MFMA(*(const bf16x8*)(vimg + e * 2048 + (voffV0 ^ (kc << 5))), pf[kc], O[t][e]);
    }
  }
  __syncthreads();
  int tid_e = threadIdx.x;
  asm volatile("" : "+v"(tid_e));
  const int lane_e = tid_e & 63, w_e = __builtin_amdgcn_readfirstlane(tid_e >> 6), r_e = lane_e & 31, h8_e = lane_e >> 5, c_e = w_e & 1, qg_e = w_e >> 1;
  float lam;
  {
    float a = p.lq1[lane_e] * p.lk1[lane_e], b = p.lq2[lane_e] * p.lk2[lane_e];
    a = wave_sum(a); b = wave_sum(b);
    lam = __expf(a) - __expf(b) + 0.2f;
  }
  float* xch = (float*)lds;
#pragma unroll
  for (int t = 0; t < 2; ++t) {
    const float lt = l[t] + __shfl_xor(l[t], 32, 64);
    if (c_e == 1) {
      const float inv1 = lam / lt;
#pragma unroll
      for (int e = 0; e < 4; ++e)
#pragma unroll
        for (int i = 0; i < 16; ++i) xch[((qg_e * 2 + t) * 64 + e * 16 + i) * 64 + lane_e] = O[t][e][i] * inv1;
    } else {
      const float inv0 = 1.f / lt;
#pragma unroll
      for (int e = 0; e < 4; ++e)
#pragma unroll
        for (int i = 0; i < 16; ++i) O[t][e][i] *= inv0;
    }
  }
  __syncthreads();
  if (c_e == 0) {
#pragma unroll
    for (int t = 0; t < 2; ++t) {
      float ss = 0.f;
#pragma unroll
      for (int e = 0; e < 4; ++e)
#pragma unroll
        for (int i = 0; i < 16; ++i) { float o = O[t][e][i] - xch[((qg_e * 2 + t) * 64 + e * 16 + i) * 64 + lane_e]; O[t][e][i] = o; ss += o * o; }
      ss += __shfl_xor(ss, 32, 64);
      const float rstd = rsqrtf(ss * (1.f / 128.f) + 1e-6f) * 0.8f;
      bfr* dst = (bfr*)(p.ws + WS_H) + (size_t)(tok0 + q0 + qg_e * 64 + t * 32 + r_e) * D + h * 128;
#pragma unroll
      for (int e = 0; e < 4; ++e)
#pragma unroll
        for (int g = 0; g < 4; ++g) {
          const int e0 = e * 32 + 8 * g + 4 * h8_e;
          float4 gs = *(const float4*)(p.g_subln + e0);
          u32x2 o;
          o[0] = pk2(O[t][e][4 * g + 0] * rstd * gs.x, O[t][e][4 * g + 1] * rstd * gs.y);
          o[1] = pk2(O[t][e][4 * g + 2] * rstd * gs.z, O[t][e][4 * g + 3] * rstd * gs.w);
          *(u32x2*)(dst + e0) = o;
        }
    }
  }
  __syncthreads();
}

DI void conv_item(const Params& p, char* lds, int t0, int tid) {
  const int w = tid >> 6, lane = tid & 63;
  int br, s0, S; tok_info(t0, br, s0, S);
  const bfr* Z = (const bfr*)(p.ws + WS_Z);
  unsigned* zl = (unsigned*)lds;
  float* red = (float*)(lds + 63488);
  __syncthreads();
  for (int idx = tid; idx < 62 * 64; idx += 256) {
    const int row = idx >> 6, c16 = idx & 63;
    const int s = s0 - 15 + row;
    u32x4 v = {0u, 0u, 0u, 0u};
    if (s >= 0 && s < S) v = *(const u32x4*)(Z + (size_t)(t0 - 15 + row) * 512 + c16 * 8);
    *(u32x4*)(zl + row * 256 + c16 * 4) = v;
  }
  float wa[31], wb[31];
#pragma unroll
  for (int j = 0; j < 31; ++j) { float2 ww = *(const float2*)(p.w_dw + j * 512 + tid * 2); wa[j] = ww.x; wb[j] = ww.y; }
  const float2 bias = *(const float2*)(p.b_dw + tid * 2);
  __syncthreads();
  const float2 gl = *(const float2*)(p.g_cln + tid * 2), bl = *(const float2*)(p.b_cln + tid * 2);
  unsigned* Hu = (unsigned*)(p.ws + WS_H);
#pragma unroll 1
  for (int ps = 0; ps < 4; ++ps) {
    float za[38], zb[38];
#pragma unroll
    for (int rr = 0; rr < 38; ++rr) {
      const unsigned u = zl[(ps * 8 + rr) * 256 + tid];
      za[rr] = __uint_as_float(u << 16); zb[rr] = __uint_as_float(u & 0xffff0000u);
    }
    float ya[8], yb[8];
#pragma unroll
    for (int i = 0; i < 8; ++i) {
      float a = bias.x, b = bias.y;
#pragma unroll
      for (int j = 0; j < 31; ++j) { a += wa[j] * za[i + j]; b += wb[j] * zb[i + j]; }
      ya[i] = a; yb[i] = b;
    }
#pragma unroll
    for (int i = 0; i < 8; ++i) {
      float s1 = wave_sum(ya[i] + yb[i]);
      float s2 = wave_sum(ya[i] * ya[i] + yb[i] * yb[i]);
      if (lane == 0) { red[(w * 8 + i) * 2] = s1; red[(w * 8 + i) * 2 + 1] = s2; }
    }
    __syncthreads();
#pragma unroll
    for (int i = 0; i < 8; ++i) {
      const float s1 = red[(0 * 8 + i) * 2] + red[(1 * 8 + i) * 2] + red[(2 * 8 + i) * 2] + red[(3 * 8 + i) * 2];
      const float s2 = red[(0 * 8 + i) * 2 + 1] + red[(1 * 8 + i) * 2 + 1] + red[(2 * 8 + i) * 2 + 1] + red[(3 * 8 + i) * 2 + 1];
      const float mu = s1 * (1.f / 512.f);
      const float var = fmaxf(s2 * (1.f / 512.f) - mu * mu, 0.f);
      const float rstd = rsqrtf(var + 1e-6f);
      float a = (ya[i] - mu) * rstd * gl.x + bl.x, b = (yb[i] - mu) * rstd * gl.y + bl.y;
      a = a / (1.f + __expf(-a)); b = b / (1.f + __expf(-b));
      Hu[((size_t)(t0 + ps * 8 + i) * D + 512) / 2 + tid] = pk2(a, b);
    }
    __syncthreads();
  }
}

DI void phase3(const Params& p, char* lds) {
  const int n_s = 512, n_p = 1024, n_c = T / 32;
  for (int it = blockIdx.x; it < n_s + n_p; it += gridDim.x) {
    int S, b, h, qt, tok0; size_t gb;
    if (it < n_s) {
      const int bh = it & 7; qt = it >> 3; b = bh >> 2; h = bh & 3; S = 16384;
      gb = (size_t)TP * 512 + (size_t)b * 16384 * 512; tok0 = TP + b * 16384;
    } else {
      const int i2 = it - n_s, x = i2 & 7, y = i2 >> 3;
      const int bh = x + 8 * (y >> 4); qt = y & 15; b = bh >> 2; h = bh & 3; S = 4096;
      gb = (size_t)b * 4096 * 512; tok0 = b * 4096;
    }
    unsigned char* ws = p.ws;
    asm volatile("" : "+s"(ws));
    const bfr* Qg = (const bfr*)(ws + WS_Q);
    const bfr* Kg = (const bfr*)(ws + WS_K);
    const bfr* Vg = (const bfr*)(ws + WS_VT);
    attn_item(p, lds, S, Qg + gb, Kg + gb, Vg + gb + (size_t)h * 128 * S, h, qt * 256, tok0);
  }
  {
    const int vb = threadIdx.x >> 8, vtid = threadIdx.x & 255;
    for (int it0 = blockIdx.x; it0 < n_c / 2; it0 += gridDim.x) conv_item(p, lds + vb * VLDS, (it0 * 2 + vb) * 32, vtid);
  }
}

DI void phase4(const Params& p, char* lds) {
  const bfr* H = (const bfr*)(p.ws + WS_H);
  const bfr* Wt = (const bfr*)(p.ws + WS_WOUT);
  const float* mod = (const float*)(p.ws + WS_MOD);
  const bfr* Cs0 = (const bfr*)lds;
  XSched xs; xs.init(384, 4);
  int mt, nt2;
  while (xs.next(mt, nt2)) {
    const int t0 = mt * 256;
    int br, s0, S; tok_info(t0, br, s0, S);
    auto arow = [&](int row) { return H + (size_t)(t0 + row) * D; };
    auto brow = [&](int row) { return Wt + (size_t)(nt2 * 256 + row) * 32; };
    auto epi = [&](int half, int ch, int tid) {
      const bfr* Cs = Cs0 + half * 128 * CSS + ch * 128;
      const int c4 = (tid & 31) * 4, col = nt2 * 256 + ch * 128 + c4, t0h = t0 + half * 128;
      const float4 g1 = *(const float4*)(mod + br * 6144 + 2 * 1024 + col);
      float4 xv[16];
#pragma unroll
      for (int ps = 0; ps < 16; ++ps) xv[ps] = *(const float4*)(xrow(p, t0h + ps * 8 + (tid >> 5)) + col);
      asm volatile("" ::: "memory");
#pragma unroll
      for (int ps = 0; ps < 16; ++ps) {
        const int row = ps * 8 + (tid >> 5), t = t0h + row;
        float4 c = cs4(Cs, row, c4);
        float4 o = make_float4(xv[ps].x + g1.x * c.x, xv[ps].y + g1.y * c.y, xv[ps].z + g1.z * c.z, xv[ps].w + g1.w * c.w);
        *(float4*)(p.out + (size_t)t * D + col) = o;
      }
    };
    gemm_tile(lds, 1024, 32, 1024 * 32, arow, brow, epi);
  }
}

DI void phase5(const Params& p, char* lds0) {
  const int vb = threadIdx.x >> 8, tid = threadIdx.x & 255, w = tid >> 6, lane = tid & 63;
  char* lds = lds0 + vb * 4096;
  const float* mod = (const float*)(p.ws + WS_MOD);
  const float* wrt = (const float*)(p.ws + WS_WRT);
  bfr* H = (bfr*)(p.ws + WS_H);
  int* cnt = (int*)(p.ws + WS_CNT) + p.dummy * 64;
  int* list = (int*)(p.ws + WS_LIST) + (size_t)p.dummy * 8388608;
  float* gate = (float*)(p.ws + WS_GATE);
  int* hist = (int*)lds;
  int* base = hist + 64;
  int* info = base + 64;
  float* wg = (float*)(lds0 + 8192);
  __syncthreads();
  for (int i = threadIdx.x; i < 36 * 256; i += NT) *(float4*)(wg + i * 4) = *(const float4*)(wrt + i * 4);
  __syncthreads();
  for (int chunk0 = blockIdx.x; chunk0 < T / 128; chunk0 += gridDim.x) {
    const int chunk = chunk0 * 2 + vb;
    __syncthreads();
    if (tid < 64) hist[tid] = 0;
    __syncthreads();
    const int hw = lane >> 5, l32 = lane & 31;
    float4 csv[8], shv[8];
    {
      int brc, sc_, Sc_; tok_info(chunk * 64, brc, sc_, Sc_);
      const float* shp = mod + brc * 6144 + 3 * 1024, *sclp = mod + brc * 6144 + 4 * 1024;
#pragma unroll
      for (int j = 0; j < 8; ++j) {
        const int c = j * 128 + l32 * 4;
        float4 g = *(const float4*)(p.g_norm2 + c), a = *(const float4*)(sclp + c);
        csv[j] = make_float4(g.x * (1.f + a.x), g.y * (1.f + a.y), g.z * (1.f + a.z), g.w * (1.f + a.w));
        shv[j] = *(const float4*)(shp + c);
      }
    }
    float4 nx[8];
    {
      const float* x0 = p.out + (size_t)(chunk * 64 + w * 16 + hw) * D;
#pragma unroll
      for (int j = 0; j < 8; ++j) nx[j] = *(const float4*)(x0 + j * 128 + l32 * 4);
    }
    for (int i = 0; i < 8; ++i) {
      const int tl = w * 16 + i * 2 + hw, t = chunk * 64 + tl;
      int br, s, S; tok_info(t, br, s, S);
      float hv[32];
      float ss = 0.f;
#pragma unroll
      for (int j = 0; j < 8; ++j) {
        float4 v = nx[j];
        hv[j * 4 + 0] = v.x; hv[j * 4 + 1] = v.y; hv[j * 4 + 2] = v.z; hv[j * 4 + 3] = v.w;
        ss += v.x * v.x + v.y * v.y + v.z * v.z + v.w * v.w;
      }
      if (i + 1 < 8) {
        const float* x1 = p.out + (size_t)(t + 2) * D;
#pragma unroll
        for (int j = 0; j < 8; ++j) nx[j] = *(const float4*)(x1 + j * 128 + l32 * 4);
      }
#define HSUM(v) do { v += __shfl_xor(v, 16, 64); v += __shfl_xor(v, 8, 64); v += __shfl_xor(v, 4, 64); v += __shfl_xor(v, 2, 64); v += __shfl_xor(v, 1, 64); } while (0)
      HSUM(ss);
      const float rstd = rsqrtf(ss * (1.f / 1024.f) + 1e-6f);
#pragma unroll
      for (int j = 0; j < 8; ++j) {
        const int c = j * 128 + l32 * 4;
        hv[j * 4 + 0] = hv[j * 4 + 0] * rstd * csv[j].x + shv[j].x;
        hv[j * 4 + 1] = hv[j * 4 + 1] * rstd * csv[j].y + shv[j].y;
        hv[j * 4 + 2] = hv[j * 4 + 2] * rstd * csv[j].z + shv[j].z;
        hv[j * 4 + 3] = hv[j * 4 + 3] * rstd * csv[j].w + shv[j].w;
        u32x2 o; o[0] = pk2(hv[j * 4 + 0], hv[j * 4 + 1]); o[1] = pk2(hv[j * 4 + 2], hv[j * 4 + 3]);
        *(u32x2*)(H + (size_t)t * D + c) = o;
      }
      float lg[4];
#pragma unroll
      for (int n = 0; n < 4; ++n) {
        float a = 0.f;
#pragma unroll
        for (int j = 0; j < 8; ++j) {
          float4 wv = *(const float4*)(wg + n * 1024 + j * 128 + l32 * 4);
          a += hv[j * 4 + 0] * wv.x + hv[j * 4 + 1] * wv.y + hv[j * 4 + 2] * wv.z + hv[j * 4 + 3] * wv.w;
        }
        HSUM(a);
        lg[n] = a + p.b_rg[n];
      }
      int g = 0; float gm = lg[0];
#pragma unroll
      for (int n = 1; n < 4; ++n) if (lg[n] > gm) { gm = lg[n]; g = n; }
      float den = 0.f;
#pragma unroll
      for (int n = 0; n < 4; ++n) den += __expf(lg[n] - gm);
      const float pgrp = 1.f / den;
      float le[8];
#pragma unroll
      for (int e = 0; e < 8; ++e) {
        const float* wr = wg + (4 + g * 8 + e) * 1024;
        float a = 0.f;
#pragma unroll
        for (int j = 0; j < 8; ++j) {
          float4 wv = *(const float4*)(wr + j * 128 + l32 * 4);
          a += hv[j * 4 + 0] * wv.x + hv[j * 4 + 1] * wv.y + hv[j * 4 + 2] * wv.z + hv[j * 4 + 3] * wv.w;
        }
        HSUM(a);
        le[e] = a + p.b_re[g * 8 + e];
      }
#undef HSUM
      int i1 = 0; float v1 = le[0];
#pragma unroll
      for (int e = 1; e < 8; ++e) if (le[e] > v1) { v1 = le[e]; i1 = e; }
      int i2 = -1; float v2 = -3.0e38f;
#pragma unroll
      for (int e = 0; e < 8; ++e) if (e != i1 && le[e] > v2) { v2 = le[e]; i2 = e; }
      const float e2 = __expf(v2 - v1);
      const float w1 = pgrp / (1.f + e2), w2 = pgrp * e2 / (1.f + e2);
      if (l32 == 0) {
        const int li0 = (g * 8 + i1) * 2, li1 = (g * 8 + i2) * 2 + 1;
        const int lp0 = atomicAdd(&hist[li0], 1), lp1 = atomicAdd(&hist[li1], 1);
        info[tl * 4 + 0] = li0; info[tl * 4 + 1] = li1; info[tl * 4 + 2] = lp0; info[tl * 4 + 3] = lp1;
        gate[t] = w1; gate[T + t] = w2;
      }
    }
    __syncthreads();
    if (tid < 64) { const int hcnt = hist[tid]; base[tid] = hcnt ? atomicAdd(&cnt[tid], hcnt) : 0; }
    __syncthreads();
    if (tid < 64) {
      const int t = chunk * 64 + tid;
      const int li0 = info[tid * 4 + 0], li1 = info[tid * 4 + 1];
      list[(size_t)li0 * T + base[li0] + info[tid * 4 + 2]] = t;
      list[(size_t)li1 * T + base[li1] + info[tid * 4 + 3]] = t;
    }
  }
  __syncthreads();
}

DI void phase_moe(const Params& p, char* lds, int mode) {
  const int tid = threadIdx.x;
  unsigned char* ws = p.ws;
  const int* cnt = (const int*)(ws + WS_CNT);
  const int* list = (const int*)(ws + WS_LIST);
  const bfr* H = (const bfr*)(ws + WS_H);
  bfr* act = (bfr*)(ws + WS_ACT);
  const float* gate = (const float*)(ws + WS_GATE);
  const float* mod = (const float*)(ws + WS_MOD);
  const bfr* Cs0 = (const bfr*)lds;
  int* pre = (int*)(lds + 135168);
  int* rowtok = pre + 72;
  float* g2t = (float*)(lds + 136704);
  int* lb = (int*)(lds + 155136);
  const int nl = mode == 0 ? 64 : 32;
  __syncthreads();
  if (tid == 0) {
    int a = 0;
    for (int i = 0; i < nl; ++i) { pre[i] = a; const int li = mode == 0 ? i : i * 2 + (mode - 1); a += (cnt[li] + 255) >> 8; }
    pre[nl] = a;
    int b = 0;
    for (int i = 0; i < 64; ++i) { lb[i] = b; b += cnt[i]; }
  }
  __syncthreads();
  XSched xs; xs.init(pre[nl], 4);
  int tile, nt2;
  while (xs.next(tile, nt2)) {
    int sl = 0;
    while (pre[sl + 1] <= tile) ++sl;
    const int li = mode == 0 ? sl : sl * 2 + (mode - 1);
    const int e = li >> 1, k = li & 1;
    const int r0 = (tile - pre[sl]) * 256, n = cnt[li];
    if (tid < 256) { int idx = r0 + tid; if (idx >= n) idx = n - 1; rowtok[tid] = list[(size_t)li * T + idx]; }
    if (mode == 2) {
      for (int i = tid; i < NBR * 64; i += NT) {
        const int brr = i >> 6, cc = (i & 63) * 4;
        *(float4*)(g2t + brr * 256 + cc) = *(const float4*)(mod + brr * 6144 + 5 * 1024 + nt2 * 256 + cc);
      }
    }
    __syncthreads();
    if (mode == 0) {
      const bfr* Wt = (const bfr*)(ws + WS_WGU) + (size_t)e * 1024 * 1024;
      auto arow = [&](int row) { return H + (size_t)rowtok[row] * D; };
      auto brow = [&](int row256) { const int nt = nt2 * 2 + (row256 >> 7), row = row256 & 127; const int c = row < 64 ? nt * 64 + row : 512 + nt * 64 + (row - 64); return Wt + (size_t)c * 32; };
      auto epi = [&](int half, int ch, int tid) {
        const int nt = nt2 * 2 + ch;
        const bfr* Cs = Cs0 + half * 128 * CSS + ch * 128;
        const int row = tid & 127, hf = tid >> 7, grow = half * 128 + row;
        if (r0 + grow < n) {
          bfr* dst = act + ((size_t)(nt * 2 + hf) * (2 * T) + (lb[li] + r0 + grow)) * 32;
#pragma unroll
          for (int q = 0; q < 4; ++q) {
            float z[8];
#pragma unroll
            for (int u = 0; u < 2; ++u) {
              float4 g = cs4(Cs, row, hf * 32 + q * 8 + u * 4);
              float4 up = cs4(Cs, row, 64 + hf * 32 + q * 8 + u * 4);
              z[u * 4 + 0] = g.x / (1.f + __expf(-g.x)) * up.x; z[u * 4 + 1] = g.y / (1.f + __expf(-g.y)) * up.y;
              z[u * 4 + 2] = g.z / (1.f + __expf(-g.z)) * up.z; z[u * 4 + 3] = g.w / (1.f + __expf(-g.w)) * up.w;
            }
            u32x4 o; o[0] = pk2(z[0], z[1]); o[1] = pk2(z[2], z[3]); o[2] = pk2(z[4], z[5]); o[3] = pk2(z[6], z[7]);
            *(u32x4*)(dst + q * 8) = o;
          }
        }
      };
      gemm_tile(lds, 1024, 32, 1024 * 32, arow, brow, epi);
    } else {
      const bfr* Wt = (const bfr*)(ws + WS_WD) + (size_t)e * 1024 * 512;
      auto arow = [&](int row) { int sl_ = lb[li] + r0 + row; if (sl_ > 2 * T - 1) sl_ = 2 * T - 1; return act + (size_t)sl_ * 32; };
      auto brow = [&](int row) { return Wt + (size_t)(nt2 * 256 + row) * 32; };
      bfr* Y0 = (bfr*)(ws + WS_H);
      auto epi = [&](int half, int ch, int tid) {
        const bfr* Cs = Cs0 + half * 128 * CSS + ch * 128;
        const int c4 = (tid & 31) * 4, col = nt2 * 256 + ch * 128 + c4;
        if (mode == 1) {
          float gt[16]; int tk[16];
#pragma unroll
          for (int ps = 0; ps < 16; ++ps) {
            const int grow = half * 128 + ps * 8 + (tid >> 5);
            tk[ps] = rowtok[grow];
            gt[ps] = gate[(size_t)k * T + tk[ps]];
          }
          asm volatile("" ::: "memory");
#pragma unroll
          for (int ps = 0; ps < 16; ++ps) {
            const int row = ps * 8 + (tid >> 5);
            if (r0 + half * 128 + row < n) {
              float4 c = cs4(Cs, row, c4);
              const float g = gt[ps];
              u32x2 o; o[0] = pk2(g * c.x, g * c.y); o[1] = pk2(g * c.z, g * c.w);
              *(u32x2*)(Y0 + (size_t)tk[ps] * D + col) = o;
            }
          }
        } else {
          float4 ov[16]; u32x2 yv[16]; float gt[16]; int tk[16];
#pragma unroll
          for (int ps = 0; ps < 16; ++ps) {
            const int grow = half * 128 + ps * 8 + (tid >> 5);
            tk[ps] = rowtok[grow];
            gt[ps] = gate[(size_t)k * T + tk[ps]];
            ov[ps] = *(const float4*)(p.out + (size_t)tk[ps] * D + col);
            yv[ps] = *(const u32x2*)(Y0 + (size_t)tk[ps] * D + col);
          }
          asm volatile("" ::: "memory");
#pragma unroll
          for (int ps = 0; ps < 16; ++ps) {
            const int row = ps * 8 + (tid >> 5);
            if (r0 + half * 128 + row < n) {
              int br, s_, S_; tok_info(tk[ps], br, s_, S_);
              const float4 g2 = *(const float4*)(g2t + br * 256 + ch * 128 + c4);
              float4 c = cs4(Cs, row, c4);
              float4 o = ov[ps];
              const float g = gt[ps];
              o.x += g2.x * (__uint_as_float(yv[ps][0] << 16) + g * c.x);
              o.y += g2.y * (__uint_as_float(yv[ps][0] & 0xffff0000u) + g * c.y);
              o.z += g2.z * (__uint_as_float(yv[ps][1] << 16) + g * c.z);
              o.w += g2.w * (__uint_as_float(yv[ps][1] & 0xffff0000u) + g * c.w);
              *(float4*)(p.out + (size_t)tk[ps] * D + col) = o;
            }
          }
        }
      };
      gemm_tile(lds, 512, 2 * T * 32, 1024 * 32, arow, brow, epi);
    }
    __syncthreads();
  }
}

__global__ void __launch_bounds__(NT, 2) fwd_kernel(Params p) {
  __shared__ __attribute__((aligned(1024))) char lds[LDS_BYTES];
  cg::grid_group grid = cg::this_grid();
  const int lo = p.ph_lo, hi = p.ph_hi;
#define RUN(k, call) if (lo <= (k) && (k) < hi) { if ((k) > lo) grid.sync(); if (PHMASK & (1 << (k))) { call; } }
  RUN(0, phase0(p, lds))
  RUN(1, phase1(p))
  RUN(2, phase2(p, lds))
  RUN(3, phase3(p, lds))
  RUN(4, phase4(p, lds))
  RUN(5, phase5(p, lds))
  RUN(6, phase_moe(p, lds, 0))
  RUN(7, phase_moe(p, lds, 1))
  RUN(8, phase_moe(p, lds, 2))
#undef RUN
}

extern "C" void kernel_launch(void* const* d_in, const int* in_sizes, int n_in, void* d_out, int out_size, void* d_ws, size_t ws_size,
                              hipStream_t stream) {
  static int grid_blocks = 0;
  if (!grid_blocks) {
    int dev = 0, cus = 0, per_cu = 0;
    hipGetDevice(&dev);
    hipDeviceGetAttribute(&cus, hipDeviceAttributeMultiprocessorCount, dev);
    hipOccupancyMaxActiveBlocksPerMultiprocessor(&per_cu, fwd_kernel, NT, 0);
    if (per_cu < 1) per_cu = 1;
    if (per_cu > 1) per_cu = 1;
    grid_blocks = cus * per_cu;
  }
  Params p;
  memset(&p, 0, sizeof(p));
  const float** f = (const float**)&p.xp;
  for (int i = 0; i < 27; ++i) f[i] = (const float*)d_in[i];
  p.out = (float*)d_out;
  p.ws = (unsigned char*)d_ws;
  for (int i = 0; i < 8; ++i) p.inv_freq[i] = pow(500000.0, -(2.0 * i) / 16.0);
#if N_LAUNCH_MODE == 1
  for (int ph = 0; ph < NPHASE; ++ph) {
    p.ph_lo = ph; p.ph_hi = ph + 1;
    hipLaunchKernelGGL(fwd_kernel, dim3(grid_blocks), dim3(NT), 0, stream, p);
    if (PROBE_MASK & (1 << ph)) { p.dummy = 1; hipLaunchKernelGGL(fwd_kernel, dim3(grid_blocks), dim3(NT), 0, stream, p); p.dummy = 0; }
  }
#else
  p.ph_lo = 0; p.ph_hi = NPHASE;
  void* args[] = {&p};
  hipLaunchCooperativeKernel((const void*)fwd_kernel, dim3(grid_blocks), dim3(NT), args, 0, stream);
#endif
}
```
